# Optimizing an MI355X kernel written in HIP

```python
import math
import jax, jax.numpy as jnp
from jax import lax
import numpy as np

D_MODEL = 1024
BATCH = 32
SEQ = 256
DEPTH = 4
DEC_BATCH = 8
DEC_SEQ = 2048
PAST_LEN = 512

GRID_W = 64
ATT_HEADS = 4
QK_HEAD_DIM = 64
V_HEAD_DIM = 2 * QK_HEAD_DIM
ATT_WIDTH = ATT_HEADS * V_HEAD_DIM
QK_COLS = ATT_HEADS * 2 * QK_HEAD_DIM
ROPE_BASE = 10000.0
Q_BLOCK = 128
CONV_WIDTH = D_MODEL // 4
CONV_KERNEL = 31
POOL_WIDTH = D_MODEL // 4
POOL_WINDOWS = (2, 4, 8, 16)
POOL_GROUPS = 4
POOL_GROUP_DIM = POOL_WIDTH // POOL_GROUPS
N_BRANCH = 3
IN_COLS = 2 * QK_COLS + ATT_WIDTH + 2 * CONV_WIDTH + POOL_WIDTH + N_BRANCH * D_MODEL
D_FF = ((8 * D_MODEL // 3 + 127) // 128) * 128
N_MOD = 9
ALPHA = (2 * DEPTH) ** 0.25
BETA = (8 * DEPTH) ** -0.25
LN_EPS = 1e-5

kernel_name = "hybrid_diff_conv_pool_prefix_dit_step"


def layer_norm(x, g, b):
    xf = x.astype(jnp.float32)
    mu = jnp.mean(xf, axis=-1, keepdims=True)
    var = jnp.mean(jnp.square(xf - mu), axis=-1, keepdims=True)
    y = (xf - mu) * lax.rsqrt(var + LN_EPS)
    return (y * g + b).astype(x.dtype)


def rms_norm(x, g):
    xf = x.astype(jnp.float32)
    y = xf * lax.rsqrt(jnp.mean(jnp.square(xf), axis=-1, keepdims=True) + LN_EPS)
    return (y * g).astype(x.dtype)


def swiglu(h, w_in, w_down):
    gu = h @ w_in
    g, u = jnp.split(gu, 2, axis=-1)
    return (jax.nn.silu(g) * u) @ w_down


def _rotate(seg, pos):
    nf = seg.shape[-1] // 2
    inv = ROPE_BASE ** (-jnp.arange(nf, dtype=jnp.float32) / nf)
    ang = pos.astype(jnp.float32)[:, None] * inv[None, :]
    c = jnp.cos(ang)[:, None, None, :]
    s = jnp.sin(ang)[:, None, None, :]
    x1, x2 = seg[..., :nf], seg[..., nf:]
    return jnp.concatenate([x1 * c - x2 * s, x2 * c + x1 * s], axis=-1).astype(seg.dtype)


def axial_rope(x):
    L = x.shape[1]
    rows = L // GRID_W
    row = jnp.repeat(jnp.arange(rows), GRID_W)
    col = jnp.tile(jnp.arange(GRID_W), rows)
    half = x.shape[-1] // 2
    return jnp.concatenate([_rotate(x[..., :half], row), _rotate(x[..., half:], col)], axis=-1)


def diff_attention(q, k, v, lam):
    B, Lq = q.shape[0], q.shape[1]
    qb_len = min(Q_BLOCK, Lq)
    nb = Lq // qb_len
    qb = q.reshape(B, nb, qb_len, ATT_HEADS, 2, QK_HEAD_DIM).swapaxes(0, 1)
    scale = QK_HEAD_DIM ** -0.5

    def block(qi):
        s = jnp.einsum('bqhmd,bkhmd->bhmqk', qi, k).astype(jnp.float32) * scale
        p = jax.nn.softmax(s, axis=-1)
        w = p[:, :, 0] - lam * p[:, :, 1]
        return jnp.einsum('bhqk,bkhe->bqhe', w.astype(v.dtype), v)

    o = lax.map(block, qb)
    return o.swapaxes(0, 1).reshape(B, Lq, ATT_HEADS, V_HEAD_DIM)


def depthwise_conv(u, w, b):
    C = u.shape[-1]
    y = lax.conv_general_dilated(u, w[:, None, :].astype(u.dtype), window_strides=(1,),
                                 padding=[(CONV_KERNEL // 2, CONV_KERNEL // 2)],
                                 dimension_numbers=('NWC', 'WIO', 'NWC'),
                                 feature_group_count=C)
    return y + b


def multiscale_pool(u, w_grp, scale):
    B, L, _ = u.shape
    ug = u.reshape(B, L, POOL_GROUPS, POOL_GROUP_DIM).astype(jnp.float32)
    t = jnp.arange(L)
    outs = []
    for g, win in enumerate(POOL_WINDOWS):
        ui = ug[:, :, g]
        cs = jnp.concatenate([jnp.zeros_like(ui[:, :1]), jnp.cumsum(ui, axis=1)], axis=1)
        lo = jnp.clip(t - win // 2, 0, L)
        hi = jnp.clip(t + win // 2, 0, L)
        mean = (cs[:, hi] - cs[:, lo]) / (hi - lo).astype(jnp.float32)[None, :, None]
        outs.append(jnp.einsum('blc,cd->bld', (mean - ui).astype(u.dtype), w_grp[g]))
    return jnp.concatenate(outs, axis=-1) * scale


def token_mixer(h, l, p, ctx_k, ctx_v):
    B, L, _ = h.shape
    z = h @ p["w_in"][l] + p["b_in"][l]
    pts = (QK_COLS, 2 * QK_COLS, 2 * QK_COLS + ATT_WIDTH,
           2 * QK_COLS + ATT_WIDTH + 2 * CONV_WIDTH,
           2 * QK_COLS + ATT_WIDTH + 2 * CONV_WIDTH + POOL_WIDTH)
    q, k, v, cg, pu, gt = jnp.split(z, pts, axis=-1)
    q = q.reshape(B, L, ATT_HEADS, 2, QK_HEAD_DIM)
    k = k.reshape(B, L, ATT_HEADS, 2, QK_HEAD_DIM)
    v = v.reshape(B, L, ATT_HEADS, V_HEAD_DIM)
    if ctx_k is None:
        kk, vv = k, v
    else:
        q = axial_rope(q)
        kk = jnp.concatenate([ctx_k, axial_rope(k)], axis=1)
        vv = jnp.concatenate([ctx_v, v], axis=1)
    lam_init = 0.8 - 0.6 * math.exp(-0.3 * l)
    lq = p["lambda_qk"][l].astype(jnp.float32)
    lam = jnp.exp(jnp.sum(lq[0] * lq[1])) - jnp.exp(jnp.sum(lq[2] * lq[3])) + lam_init
    o = diff_attention(q, kk, vv, lam)
    o = rms_norm(o, p["subln_g"][l]) * (1.0 - lam_init)
    att_out = o.reshape(B, L, ATT_WIDTH) @ p["w_att_o"][l]
    a, g = jnp.split(cg, 2, axis=-1)
    u = a * jax.nn.sigmoid(g)
    u = depthwise_conv(u, p["conv_dw_w"][l], p["conv_dw_b"][l])
    u = jax.nn.silu(layer_norm(u, p["conv_ln_g"][l], p["conv_ln_b"][l]))
    conv_out = u @ p["w_conv_o"][l]
    pool_out = multiscale_pool(pu, p["w_pool_g"][l], p["pool_scale"][l]) @ p["w_pool_o"][l]
    ga, gc, gp = jnp.split(jax.nn.sigmoid(gt), N_BRANCH, axis=-1)
    merged = ga * att_out + gc * conv_out + gp * pool_out
    return merged @ p["w_out"][l] + p["b_out"][l], k, v


def trunk_layer(x, cond, l, p, ctx_k, ctx_v):
    mod = jax.nn.silu(cond) @ p["w_mod"][l] + p["b_mod"][l]
    mod = mod.reshape(cond.shape[0], N_MOD, D_MODEL)[:, :, None, :]

    def modulate(i):
        return x * (1.0 + mod[:, 3 * i + 1]) + mod[:, 3 * i]

    h = modulate(0)
    x = layer_norm(ALPHA * x + 0.5 * mod[:, 2] * swiglu(h, p["w_ffn_in"][l, 0], p["w_ffn_out"][l, 0]),
                   p["ln_g"][l, 0], p["ln_b"][l, 0])
    h = modulate(1)
    mix, k, v = token_mixer(h, l, p, ctx_k, ctx_v)
    x = layer_norm(ALPHA * x + mod[:, 5] * mix, p["ln_g"][l, 1], p["ln_b"][l, 1])
    h = modulate(2)
    x = layer_norm(ALPHA * x + 0.5 * mod[:, 8] * swiglu(h, p["w_ffn_in"][l, 1], p["w_ffn_out"][l, 1]),
                   p["ln_g"][l, 2], p["ln_b"][l, 2])
    return x, k, v


def setup_inputs(seed: int = 0) -> dict:
    key = jax.random.key(seed)
    ks = iter(jax.random.split(key, 40))

    def nrm(shape, scale):
        return jax.random.normal(next(ks), shape, jnp.float32) * scale

    d = {}
    d["x_prompt"] = nrm((BATCH, SEQ, D_MODEL), 1.0)
    d["x_sample"] = nrm((DEC_BATCH, DEC_SEQ, D_MODEL), 1.0)
    d["cache_k"] = nrm((DEC_BATCH, DEPTH, PAST_LEN, ATT_HEADS, 2, QK_HEAD_DIM), 1.0)
    d["cache_v"] = nrm((DEC_BATCH, DEPTH, PAST_LEN, ATT_HEADS, V_HEAD_DIM), 1.0)
    d["c"] = nrm((DEC_BATCH, D_MODEL), 1.0)
    d["c_ctx"] = nrm((D_MODEL,), 1.0)
    d["w_mod"] = nrm((DEPTH, D_MODEL, N_MOD * D_MODEL), 0.5 * D_MODEL ** -0.5)
    d["b_mod"] = nrm((DEPTH, N_MOD * D_MODEL), 0.02)
    d["w_ffn_in"] = nrm((DEPTH, 2, D_MODEL, 2 * D_FF), D_MODEL ** -0.5)
    d["w_ffn_out"] = nrm((DEPTH, 2, D_FF, D_MODEL), BETA * D_FF ** -0.5)
    d["ln_g"] = 1.0 + nrm((DEPTH, 3, D_MODEL), 0.02)
    d["ln_b"] = nrm((DEPTH, 3, D_MODEL), 0.02)
    d["w_in"] = nrm((DEPTH, D_MODEL, IN_COLS), D_MODEL ** -0.5)
    d["b_in"] = nrm((DEPTH, IN_COLS), 0.02)
    d["lambda_qk"] = nrm((DEPTH, 4, QK_HEAD_DIM), 0.1)
    d["subln_g"] = 1.0 + nrm((DEPTH, ATT_HEADS, V_HEAD_DIM), 0.02)
    d["w_att_o"] = nrm((DEPTH, ATT_WIDTH, D_MODEL), ATT_WIDTH ** -0.5)
    d["conv_dw_w"] = nrm((DEPTH, CONV_KERNEL, CONV_WIDTH), CONV_KERNEL ** -0.5)
    d["conv_dw_b"] = nrm((DEPTH, CONV_WIDTH), 0.02)
    d["conv_ln_g"] = 1.0 + nrm((DEPTH, CONV_WIDTH), 0.02)
    d["conv_ln_b"] = nrm((DEPTH, CONV_WIDTH), 0.02)
    d["w_conv_o"] = nrm((DEPTH, CONV_WIDTH, D_MODEL), CONV_WIDTH ** -0.5)
    d["w_pool_g"] = nrm((DEPTH, POOL_GROUPS, POOL_GROUP_DIM, POOL_GROUP_DIM), POOL_GROUP_DIM ** -0.5)
    d["pool_scale"] = 1.0 + nrm((DEPTH, POOL_WIDTH), 0.02)
    d["w_pool_o"] = nrm((DEPTH, POOL_WIDTH, D_MODEL), POOL_WIDTH ** -0.5)
    d["w_out"] = nrm((DEPTH, D_MODEL, D_MODEL), BETA * D_MODEL ** -0.5)
    d["b_out"] = nrm((DEPTH, D_MODEL), 0.02)
    return d


def reference(x_prompt, x_sample, cache_k, cache_v, c, c_ctx, w_mod, b_mod, w_ffn_in, w_ffn_out,
              ln_g, ln_b, w_in, b_in, lambda_qk, subln_g, w_att_o, conv_dw_w, conv_dw_b,
              conv_ln_g, conv_ln_b, w_conv_o, w_pool_g, pool_scale, w_pool_o, w_out, b_out):
    p = dict(w_mod=w_mod, b_mod=b_mod, w_ffn_in=w_ffn_in, w_ffn_out=w_ffn_out, ln_g=ln_g, ln_b=ln_b,
             w_in=w_in, b_in=b_in, lambda_qk=lambda_qk, subln_g=subln_g, w_att_o=w_att_o,
             conv_dw_w=conv_dw_w, conv_dw_b=conv_dw_b, conv_ln_g=conv_ln_g, conv_ln_b=conv_ln_b,
             w_conv_o=w_conv_o, w_pool_g=w_pool_g, pool_scale=pool_scale, w_pool_o=w_pool_o,
             w_out=w_out, b_out=b_out)
    xp = x_prompt
    cond_ctx = c_ctx[None, :]
    ks_new, vs_new = [], []
    for l in range(DEPTH):
        xp, k_l, v_l = trunk_layer(xp, cond_ctx, l, p, None, None)
        ks_new.append(k_l)
        vs_new.append(v_l)
    new_cache_k = jnp.stack(ks_new, axis=1)
    new_cache_v = jnp.stack(vs_new, axis=1)
    xs = x_sample
    for l in range(DEPTH):
        xs, _, _ = trunk_layer(xs, c, l, p, cache_k[:, l], cache_v[:, l])
    return (xp, xs, new_cache_k, new_cache_v)
```

```cpp
#include <hip/hip_runtime.h>
#include <hip/hip_cooperative_groups.h>
#include <cstdio>
namespace cg = cooperative_groups;

typedef _Float16 h16;
typedef h16 h16x8 __attribute__((ext_vector_type(8)));
typedef h16 h16x4 __attribute__((ext_vector_type(4)));
typedef h16 h16x2 __attribute__((ext_vector_type(2)));
typedef float f32x4 __attribute__((ext_vector_type(4)));
typedef float f32x16 __attribute__((ext_vector_type(16)));

constexpr int D = 1024, MT = 24576, MP = 8192, DFF = 2816, NUP = 5632, INC = 5376, NMODC = 9216;
constexpr float ALPHA = 1.681792830507429f;
constexpr float LN_EPS = 1e-5f;
constexpr size_t OUT_K = (size_t)MT * D;
constexpr size_t OUT_V = OUT_K + (size_t)32 * 4 * 256 * 512;

enum { I_XP = 0, I_XS, I_CK, I_CV, I_C, I_CCTX, I_WMOD, I_BMOD, I_WFIN, I_WFOUT, I_LNG, I_LNB, I_WIN, I_BIN, I_LAM, I_SUBG,
       I_WATT, I_CDW, I_CDB, I_CLG, I_CLB, I_WCONV, I_WPG, I_PSC, I_WPO, I_WOUT, I_BOUT };

constexpr size_t SZ_WUP = (size_t)4 * 2 * NUP * D * 2, SZ_WDN = (size_t)4 * 2 * D * DFF * 2, SZ_WIN = (size_t)4 * INC * D * 2;
constexpr size_t SZ_WATT = (size_t)4 * D * 512 * 2, SZ_WCONV = (size_t)4 * D * 256 * 2, SZ_WPOOL = SZ_WCONV, SZ_WOUT = (size_t)4 * D * D * 2;
constexpr size_t SZ_MOD = (size_t)9 * 4 * NMODC * 4, SZ_X = (size_t)MT * D * 4, SZ_H = (size_t)MT * D * 2, SZ_ACT = (size_t)MT * 3072 * 2;
constexpr size_t SZ_Q = (size_t)MT * 512 * 2, SZ_KP = (size_t)32 * 256 * 512 * 2, SZ_KS = (size_t)8 * 2560 * 512 * 2, SZ_VTP = SZ_KP, SZ_VTS = SZ_KS;
constexpr size_t SZ_U = (size_t)MT * 256 * 2;
constexpr size_t OFF_WUP = 0, OFF_WDN = OFF_WUP + SZ_WUP, OFF_WIN = OFF_WDN + SZ_WDN, OFF_WATT = OFF_WIN + SZ_WIN, OFF_WCONV = OFF_WATT + SZ_WATT,
                 OFF_WPOOL = OFF_WCONV + SZ_WCONV, OFF_WOUT = OFF_WPOOL + SZ_WPOOL, OFF_MOD = OFF_WOUT + SZ_WOUT, OFF_X = OFF_MOD + SZ_MOD,
                 OFF_H = OFF_X + SZ_X, OFF_ACT = OFF_H + SZ_H, OFF_Q = OFF_ACT + SZ_ACT, OFF_KP = OFF_Q + SZ_Q, OFF_KS = OFF_KP + SZ_KP,
                 OFF_VTP = OFF_KS + SZ_KS, OFF_VTS = OFF_VTP + SZ_VTP, OFF_U = OFF_VTS + SZ_VTS, OFF_PU = OFF_U + SZ_U, OFF_OATT = OFF_PU + SZ_U,
                 OFF_UC = OFF_OATT + SZ_Q, OFF_PL = OFF_UC + SZ_U, OFF_MG = OFF_PL + SZ_U, OFF_XB = OFF_MG + SZ_H, WS_END = OFF_XB + (size_t)96 * 256 * 4 * 8;
constexpr size_t CTL_BYTES = 4096 + (size_t)12 * 96 * 64;

constexpr int LDS_BYTES = 128 * 1024 + 10240;

struct Params { const float* in[27]; float* out; unsigned char* ws; };

typedef const float* const __attribute__((address_space(4))) * InTab;
struct Ctx {
  InTab in; float* out; unsigned char* ws; unsigned char* lds;
  int tid, bx, G;
};
#define CLANE (c.tid & 63)
#define CWAVE (__builtin_amdgcn_readfirstlane(c.tid >> 6))

__device__ __forceinline__ int cond_row(int t) { return t < MP ? 0 : 1 + ((t - MP) >> 11); }
__device__ __forceinline__ float shx(float v, int o, int lane) {
  return __int_as_float(__builtin_amdgcn_ds_bpermute((lane ^ o) << 2, __float_as_int(v)));
}
__device__ __forceinline__ float wave_sum(float v, int lane) {
#pragma unroll
  for (int o = 32; o >= 1; o >>= 1) v += shx(v, o, lane);
  return v;
}
__device__ __forceinline__ void st_wt(void* p, f32x4 v) { asm volatile("global_store_dwordx4 %0, %1, off sc1\n\ts_nop 1" :: "v"(p), "v"(v) : "memory"); }
__device__ __forceinline__ void st_wt(void* p, h16x8 v) { st_wt(p, __builtin_bit_cast(f32x4, v)); }
__device__ __forceinline__ float sigmoidf_(float x) { return __builtin_amdgcn_rcpf(1.f + __expf(-x)); }

#define LAS __attribute__((address_space(3)))
constexpr int BM = 256, BK = 64, HALF = 128, HTB = HALF * BK * 2, NXCD = 8, WGM = 8;
__device__ __forceinline__ int lds_byte(int r, int c) {
  const int st = (r >> 4) * 2 + (c >> 5), rr = r & 15, cc = c & 31, ob = rr * 64 + cc * 2;
  return st * 1024 + (ob ^ (((ob >> 9) & 1) << 5));
}
__device__ __forceinline__ void stage_rc(int b, int& R, int& C) {
  const int st = b / 1024, sb = b % 1024, swz = sb ^ (((sb >> 9) & 1) << 5);
  R = (st >> 1) * 16 + swz / 64; C = (st & 1) * 32 + (swz % 64) / 2;
}
struct Unit { int pm, pn; };
struct StaticOrder {
  int nM, nN, nwg, G, c; bool panel;
  __device__ __forceinline__ void init(int M, int N, int G_, int c_) { nM = M / BM; nN = N / BM; nwg = nM * nN; G = G_; c = c_; }
  __device__ __forceinline__ bool next(int i, Unit& u) const {
    const long L = (long)i * G + c; if (L >= nwg) return false;
    if (panel) {
      if (G == 256) { const int r = (int)(L >> 8), cc = (int)(L & 255), x = cc & 7, j = cc >> 3; u.pn = j & 3; u.pm = r == 0 ? x * 8 + (j >> 2) : 64 + x * 4 + (j >> 2); return true; }
      u.pm = (int)(L >> 2); u.pn = (int)(L & 3); return true;
    }
    int wgid = (int)L; { const int q = nwg / NXCD, r = nwg % NXCD, xcd = wgid % NXCD, off = wgid / NXCD; wgid = (xcd < r ? xcd * (q + 1) : r * (q + 1) + (xcd - r) * q) + off; }
    const int nig = WGM * nN, gid = wgid / nig, fm = gid * WGM, gsz = (nM - fm) < WGM ? (nM - fm) : WGM;
    u.pm = fm + ((wgid % nig) % gsz); u.pn = (wgid % nig) / gsz; return true;
  }
};

template <class Epi>
__device__ __forceinline__ void gemm_stream(int tid, int bx, int G, LAS unsigned char* lds, const h16* Ag, const h16* Btg, int N, int K, const Epi& E, int lsel = 0) {
  const int  wid = __builtin_amdgcn_readfirstlane(tid >> 6), lane = tid & 63, wr = wid >> 2, wc = wid & 3, fr = lane & 15, fq = lane >> 4;
  const int nt = K / BK;
  unsigned voff[2];
#pragma unroll
  for (int i = 0; i < 2; ++i) { int R, C; stage_rc(tid * 16 + i * 8192, R, C); voff[i] = (unsigned)(R * K + C) * 2u; }
  const size_t kstep = (size_t)(BK * 2);
  const size_t hstep = (size_t)HALF * K * 2;
  const size_t tstep = 2 * hstep;
  const unsigned ldsw = (unsigned)wid * 1024u;
  const int aoff = lds_byte(wr * 64 + fr, fq * 8), boff = lds_byte(wc * 32 + fr, fq * 8);
#define PG8_SA(b, h) (((b) * 2 + (h)) * HTB)
#define PG8_SB(b, h) ((4 + (b) * 2 + (h)) * HTB)
#define PG8_STAGE(bufoff, gbase) do { _Pragma("unroll") for (int _i = 0; _i < 2; ++_i) \
    __builtin_amdgcn_global_load_lds((const unsigned*)((const char*)(gbase) + voff[_i]), (LAS unsigned*)(lds + (bufoff) + ldsw + _i * 8192), 16, 0, 0); } while (0)
#define PG8_LDA(dst, b, h) do { _Pragma("unroll") for (int m = 0; m < 4; ++m) _Pragma("unroll") for (int k = 0; k < 2; ++k) dst[m][k] = *(const LAS h16x8*)(lds + PG8_SA(b, h) + aoff + m * 2048 + k * 1024); } while (0)
#define PG8_LDB(dst, b, h) do { _Pragma("unroll") for (int n = 0; n < 2; ++n) _Pragma("unroll") for (int k = 0; k < 2; ++k) dst[n][k] = *(const LAS h16x8*)(lds + PG8_SB(b, h) + boff + n * 2048 + k * 1024); } while (0)
#define PG8_MMA(ai, bj, At, Bt) do { __builtin_amdgcn_s_setprio(1); _Pragma("unroll") for (int m = 0; m < 4; ++m) _Pragma("unroll") for (int n = 0; n < 2; ++n) _Pragma("unroll") for (int k = 0; k < 2; ++k) \
    acc[ai][bj][m][n] = __builtin_amdgcn_mfma_f32_16x16x32_f16(Bt[n][k], At[m][k], acc[ai][bj][m][n], 0, 0, 0); __builtin_amdgcn_s_setprio(0); } while (0)
#define PG8_WAIT_V(n) asm volatile("s_waitcnt vmcnt(" #n ")" ::: "memory")
#define PG8_WAIT_L(n) asm volatile("s_waitcnt lgkmcnt(" #n ")" ::: "memory")
#define PG8_BAR __builtin_amdgcn_s_barrier()
#define PG8_SCHED __builtin_amdgcn_sched_barrier(0)
  StaticOrder S; S.init(MT, N, G, bx); S.panel = Epi::FUSED;
  Unit cur, nxt; int ui = 0;
  if (!S.next(0, cur)) return;
#define BR_A(sub) ((const char*)Ag + ((sub) == 0 ? OFF_OATT : (sub) == 1 ? OFF_OATT + (size_t)MT * 256 * 2 : (sub) == 2 ? OFF_UC : OFF_PL))
#define BR_B(sub) ((const char*)Ag + ((sub) < 2 ? OFF_WATT + (size_t)(lsel * 2 + (sub)) * D * 256 * 2 : ((sub) == 2 ? OFF_WCONV : OFF_WPOOL) + (size_t)lsel * D * 256 * 2))
  f32x4 acc[2][2][4][2];
#pragma unroll
  for (int a = 0; a < 2; ++a)
#pragma unroll
    for (int b = 0; b < 2; ++b)
#pragma unroll
      for (int m = 0; m < 4; ++m)
#pragma unroll
        for (int n = 0; n < 2; ++n) acc[a][b][m][n] = (f32x4){0.f, 0.f, 0.f, 0.f};
  h16x8 At[4][2], B0[2][2], B1[2][2];
  const char* cA = (Epi::BRANCH ? BR_A(0) : (const char*)Ag) + (size_t)cur.pm * tstep; const char* cB = (Epi::BRANCH ? BR_B(0) : (const char*)Btg) + (size_t)cur.pn * tstep;
  PG8_STAGE(PG8_SB(0, 0), cB); PG8_STAGE(PG8_SA(0, 0), cA); PG8_STAGE(PG8_SB(0, 1), cB + hstep); PG8_STAGE(PG8_SA(0, 1), cA + hstep);
  if (wr == 1) PG8_BAR;
  PG8_WAIT_V(4); PG8_BAR;
  PG8_STAGE(PG8_SB(1, 0), cB + kstep); PG8_STAGE(PG8_SA(1, 0), cA + kstep); PG8_STAGE(PG8_SB(1, 1), cB + hstep + kstep);
  PG8_WAIT_V(6); PG8_BAR;
  for (;;) {
    bool has_next; const char* nA; const char* nB;
    if constexpr (Epi::BRANCH) {
      const int nsub = (ui + 1) & 3;
      has_next = S.next((ui + 1) >> 2, nxt);
      nA = has_next ? BR_A(nsub) + (size_t)nxt.pm * tstep : cA; nB = has_next ? BR_B(nsub) + (size_t)nxt.pn * tstep : cB;
    } else {
      has_next = S.next(ui + 1, nxt);
      nA = has_next ? (const char*)Ag + (size_t)nxt.pm * tstep : cA; nB = has_next ? (const char*)Btg + (size_t)nxt.pn * tstep : cB;
    }
    for (int t = 0; t < nt; t += 2) {
      const bool last = (t == nt - 2);
      const char* a1 = cA + (size_t)(t + 1) * kstep;
      const char* a2 = last ? nA : cA + (size_t)(t + 2) * kstep; const char* b2 = last ? nB : cB + (size_t)(t + 2) * kstep;
      const char* a3 = a2 + kstep; const char* b3 = b2 + kstep;
      PG8_LDB(B0, 0, 0); PG8_SCHED; PG8_LDA(At, 0, 0); PG8_STAGE(PG8_SA(1, 1), a1 + hstep);
      PG8_WAIT_L(8); PG8_BAR; PG8_WAIT_L(0); PG8_MMA(0, 0, At, B0); PG8_BAR; PG8_SCHED;
      PG8_LDB(B1, 0, 1); PG8_STAGE(PG8_SB(0, 0), b2);
      PG8_BAR; PG8_WAIT_L(0); PG8_MMA(0, 1, At, B1); PG8_BAR;
      PG8_LDA(At, 0, 1); PG8_STAGE(PG8_SA(0, 0), a2);
      PG8_BAR; PG8_WAIT_L(0); PG8_MMA(1, 0, At, B0); PG8_BAR; PG8_SCHED;
      PG8_STAGE(PG8_SB(0, 1), b2 + hstep);
      PG8_WAIT_V(6); PG8_BAR; PG8_MMA(1, 1, At, B1); PG8_BAR;
      PG8_LDB(B0, 1, 0); PG8_SCHED; PG8_LDA(At, 1, 0); PG8_STAGE(PG8_SA(0, 1), a2 + hstep);
      PG8_WAIT_L(8); PG8_BAR; PG8_WAIT_L(0); PG8_MMA(0, 0, At, B0); PG8_BAR; PG8_SCHED;
      PG8_LDB(B1, 1, 1); PG8_STAGE(PG8_SB(1, 0), b3);
      PG8_BAR; PG8_WAIT_L(0); PG8_MMA(0, 1, At, B1); PG8_BAR;
      PG8_LDA(At, 1, 1); PG8_STAGE(PG8_SA(1, 0), a3);
      PG8_BAR; PG8_WAIT_L(0); PG8_MMA(1, 0, At, B0); PG8_BAR; PG8_SCHED;
      PG8_STAGE(PG8_SB(1, 1), b3 + hstep);
      PG8_WAIT_V(6); PG8_BAR; PG8_MMA(1, 1, At, B1); PG8_BAR;
    }
    if constexpr (Epi::FUSED) { if (wr == 0) PG8_BAR; E.fused(acc, cur.pm, cur.pn, wr, wc, fr, fq, lds + 131072, tid); if (wr == 1) PG8_BAR; }
    else if constexpr (Epi::BRANCH) { if ((ui & 3) != 0) E.branch(acc, cur.pm, cur.pn, wr, wc, fr, fq, (ui & 3) - 1); }
    else E(acc, cur.pm, cur.pn, wr, wc, fr, fq);
    if (!has_next) break;
    if (!(Epi::BRANCH && (ui & 3) != 3))
#pragma unroll
    for (int a = 0; a < 2; ++a)
#pragma unroll
      for (int b = 0; b < 2; ++b)
#pragma unroll
        for (int m = 0; m < 4; ++m)
#pragma unroll
          for (int n = 0; n < 2; ++n) acc[a][b][m][n] = (f32x4){0.f, 0.f, 0.f, 0.f};
    cur = nxt; cA = nA; cB = nB; ++ui;
  }
#undef BR_A
#undef BR_B
  PG8_WAIT_V(0);
  if (wr == 0) PG8_BAR;
  PG8_BAR;
#undef PG8_SA
#undef PG8_SB
#undef PG8_STAGE
#undef PG8_LDA
#undef PG8_LDB
#undef PG8_MMA
#undef PG8_WAIT_V
#undef PG8_WAIT_L
#undef PG8_BAR
#undef PG8_SCHED
}

struct EpiUp {       static constexpr bool FUSED = false, BRANCH = false;
  h16* ACT;
  __device__ __forceinline__ void operator()(const f32x4 (&acc)[2][2][4][2], int pm, int pn, int wr, int wc, int fr, int fq) const {
    { int t_ = fr | (fq << 4); asm volatile("" : "+v"(t_)); fr = t_ & 15; fq = t_ >> 4; }
#pragma unroll
    for (int ai = 0; ai < 2; ++ai)
#pragma unroll
      for (int m = 0; m < 4; ++m) {
        const int row = pm * 256 + ai * 128 + wr * 64 + m * 16 + fr;
        h16x8 o;
#pragma unroll
        for (int n = 0; n < 2; ++n)
#pragma unroll
          for (int e = 0; e < 4; ++e) { const float g = acc[ai][0][m][n][e], u = acc[ai][1][m][n][e]; o[4 * n + e] = (h16)(g * sigmoidf_(g) * u); }
        st_wt(ACT + (size_t)row * DFF + pn * 128 + wc * 32 + 8 * fq, o);
      }
  }
};
#define XBAR() do { asm volatile("s_waitcnt lgkmcnt(0)" ::: "memory"); __builtin_amdgcn_s_barrier(); asm volatile("" ::: "memory"); } while (0)
struct EpiResLn {
  static constexpr bool FUSED = true, BRANCH = false;
  unsigned char* ws; InTab in; float* out; int l, s;
  __device__ __forceinline__ void fused(f32x4 (&acc)[2][2][4][2], int pm, int pn, int wr, int wc, int fr, int fq, LAS unsigned char* lx, int tid) const {
    int l_ = l;
    asm volatile("" : "+v"(tid), "+s"(l_)); fr = tid & 15; fq = (tid >> 4) & 3;
    const int sub = (s == 1) ? 0 : (s == 5 ? 1 : 2);
    const bool first = (l_ == 0 && s == 1), last = (l_ == 3 && s == 7);
    const int lnx = (sub == 2) ? l_ + 1 : l_, inx = (sub == 2) ? 0 : sub + 1;
    const float* MOD = (const float*)(ws + OFF_MOD);
    h16* X = (h16*)(ws + OFF_X);
    const float* srcP = in[I_XP]; const float* srcS = in[I_XS] - (size_t)MP * D;
    float* dstX = out; h16* H = (h16*)(ws + OFF_H);
    const float* MODg = MOD + (size_t)l_ * NMODC + (s == 1 ? 2 : (s == 5 ? 5 : 8)) * D;
    const float* bias = (s == 5) ? in[I_BOUT] + (size_t)l_ * D : nullptr; const float coef = (s == 5) ? 1.f : 0.5f;
    const float* lng = in[I_LNG] + (size_t)(l_ * 3 + sub) * D; const float* lnb = in[I_LNB] + (size_t)(l_ * 3 + sub) * D;
    const float* MODn = last ? nullptr : MOD + (size_t)lnx * NMODC + (size_t)(3 * inx) * D;
    unsigned long long* xb = (unsigned long long*)(ws + OFF_XB); unsigned* cnt = (unsigned*)(ws + WS_END + 4096) + (size_t)(l_ * 3 + sub) * 96 * 16;
    typedef float f32x2 __attribute__((ext_vector_type(2)));
    LAS f32x2* P = (LAS f32x2*)lx;
    LAS f32x2* St = (LAS f32x2*)(lx + 8192);
    const int brow = pm * 256;
    const int crow = cond_row(brow);
    const float* gate = MODg + (size_t)crow * 4 * NMODC;
    const float* src = (brow < MP) ? srcP : srcS;
    f32x4 gt[2][2], bb[2][2];
#pragma unroll
    for (int bj = 0; bj < 2; ++bj)
#pragma unroll
      for (int n = 0; n < 2; ++n) {
        const int cb = pn * 256 + bj * 128 + wc * 32 + 8 * fq + 4 * n;
        gt[bj][n] = *(const f32x4*)(gate + cb) * coef; bb[bj][n] = bias ? *(const f32x4*)(bias + cb) : (f32x4){0.f, 0.f, 0.f, 0.f};
      }
#pragma unroll
    for (int ai = 0; ai < 2; ++ai)
#pragma unroll
      for (int m = 0; m < 4; ++m) {
        const int rl = ai * 128 + wr * 64 + m * 16 + fr;
        const unsigned o = (unsigned)(brow + rl) * (unsigned)D + (unsigned)(pn * 256 + wc * 32 + 8 * fq);
        f32x4 v[2][2];
        float sm = 0.f;
#pragma unroll
        for (int bj = 0; bj < 2; ++bj)
#pragma unroll
          for (int n = 0; n < 2; ++n) {
            f32x4 xs;
            if (first) xs = *(const f32x4*)(src + o + bj * 128 + 4 * n);
            else { const h16x4 xh = *(const h16x4*)(X + o + bj * 128 + 4 * n); xs = (f32x4){(float)xh[0], (float)xh[1], (float)xh[2], (float)xh[3]}; }
            v[bj][n] = xs * ALPHA + gt[bj][n] * (acc[ai][bj][m][n] + bb[bj][n]);
            sm += (v[bj][n][0] + v[bj][n][1]) + (v[bj][n][2] + v[bj][n][3]);
          }
        sm += shx(sm, 16, tid & 63); sm += shx(sm, 32, tid & 63);
        const float mw = sm * (1.f / 64.f); float q = 0.f;
#pragma unroll
        for (int bj = 0; bj < 2; ++bj)
#pragma unroll
          for (int n = 0; n < 2; ++n) { const f32x4 d = v[bj][n] - mw; q += (d[0] * d[0] + d[1] * d[1]) + (d[2] * d[2] + d[3] * d[3]); }
        q += shx(q, 16, tid & 63); q += shx(q, 32, tid & 63);
        if (fq == 0) P[rl * 4 + wc] = (f32x2){mw, q};
      }
    XBAR();
    if (tid < 256) {
      const f32x2 a = P[tid * 4 + 0], b = P[tid * 4 + 1], c2 = P[tid * 4 + 2], d = P[tid * 4 + 3];
      const float mt = (a.x + b.x + c2.x + d.x) * 0.25f;
      const float da = a.x - mt, db = b.x - mt, dc = c2.x - mt, dd = d.x - mt;
      const float M2 = (a.y + b.y + c2.y + d.y) + 64.f * (da * da + db * db + dc * dc + dd * dd);
      const unsigned long long pk = ((unsigned long long)__float_as_uint(M2) << 32) | (unsigned long long)__float_as_uint(mt);
      __hip_atomic_store(xb + ((size_t)pm * 256 + tid) * 4 + pn, pk, __ATOMIC_RELAXED, __HIP_MEMORY_SCOPE_AGENT);
    }
    asm volatile("s_waitcnt vmcnt(0)" ::: "memory");
    XBAR();
    if (tid == 0) {
      __hip_atomic_fetch_add(cnt + pm * 16, 1u, __ATOMIC_RELAXED, __HIP_MEMORY_SCOPE_AGENT);
      while (__hip_atomic_load(cnt + pm * 16, __ATOMIC_RELAXED, __HIP_MEMORY_SCOPE_AGENT) < 4u) __builtin_amdgcn_s_sleep(1);
    }
    XBAR();
    if (tid < 256) {
      float mi[4], qi[4];
#pragma unroll
      for (int j = 0; j < 4; ++j) {
        const unsigned long long pk = __hip_atomic_load(xb + ((size_t)pm * 256 + tid) * 4 + j, __ATOMIC_RELAXED, __HIP_MEMORY_SCOPE_AGENT);
        mi[j] = __uint_as_float((unsigned)(pk & 0xffffffffull)); qi[j] = __uint_as_float((unsigned)(pk >> 32));
      }
      const float mean = (mi[0] + mi[1] + mi[2] + mi[3]) * 0.25f;
      float M2 = qi[0] + qi[1] + qi[2] + qi[3];
#pragma unroll
      for (int j = 0; j < 4; ++j) { const float dm = mi[j] - mean; M2 += 256.f * dm * dm; }
      St[tid] = (f32x2){mean, rsqrtf(M2 * (1.f / D) + LN_EPS)};
    }
    XBAR();
    const float* mdn = MODn ? MODn + (size_t)crow * 4 * NMODC : nullptr;
    { int t2 = tid; asm volatile("" : "+v"(t2)); fr = t2 & 15; fq = (t2 >> 4) & 3; }
#pragma unroll
    for (int bj = 0; bj < 2; ++bj) {
      const int cb = pn * 256 + bj * 128 + wc * 32 + 8 * fq;
      f32x4 g4[2], b4[2], sh[2], sc[2], gt5[2], bb5[2];
#pragma unroll
      for (int n = 0; n < 2; ++n) {
        gt5[n] = *(const f32x4*)(gate + cb + 4 * n) * coef; bb5[n] = bias ? *(const f32x4*)(bias + cb + 4 * n) : (f32x4){0.f, 0.f, 0.f, 0.f};
        g4[n] = *(const f32x4*)(lng + cb + 4 * n); b4[n] = *(const f32x4*)(lnb + cb + 4 * n);
        if (mdn) { sh[n] = *(const f32x4*)(mdn + cb + 4 * n); sc[n] = *(const f32x4*)(mdn + D + cb + 4 * n) + 1.f; }
      }
#pragma unroll
      for (int ai = 0; ai < 2; ++ai)
#pragma unroll
        for (int m = 0; m < 4; ++m) {
          const int rl = ai * 128 + wr * 64 + m * 16 + fr;
          const f32x2 st = St[rl];
          const unsigned o = (unsigned)(brow + rl) * (unsigned)D + (unsigned)cb;
          h16x8 hv, xv;
          f32x4 xs[2];
          if (first) { xs[0] = *(const f32x4*)(src + o); xs[1] = *(const f32x4*)(src + o + 4); }
          else { const h16x8 xh = *(const h16x8*)(X + o);
#pragma unroll
            for (int e = 0; e < 4; ++e) { xs[0][e] = (float)xh[e]; xs[1][e] = (float)xh[4 + e]; } }
#pragma unroll
          for (int n = 0; n < 2; ++n) {
            const f32x4 vv = xs[n] * ALPHA + gt5[n] * (acc[ai][bj][m][n] + bb5[n]);
            const f32x4 y = (vv - st.x) * st.y * g4[n] + b4[n];
            if (last) *(f32x4*)(dstX + o + 4 * n) = y;
            else {
              const f32x4 hm = y * sc[n] + sh[n];
#pragma unroll
              for (int e = 0; e < 4; ++e) { hv[4 * n + e] = (h16)hm[e]; xv[4 * n + e] = (h16)y[e]; }
            }
          }
          if (!last) { *(h16x8*)(X + o) = xv; *(h16x8*)(H + o) = hv; }
        }
    }
  }
  __device__ __forceinline__ void operator()(const f32x4 (&acc)[2][2][4][2], int, int, int, int, int, int) const {}
};
struct EpiBranch {   static constexpr bool FUSED = false, BRANCH = true;
  const h16* Gt; h16* MG;
  __device__ __forceinline__ void operator()(const f32x4 (&acc)[2][2][4][2], int, int, int, int, int, int) const {}
  __device__ __forceinline__ void branch(f32x4 (&acc)[2][2][4][2], int pm, int pn, int wr, int wc, int fr, int fq, int pass) const {
    { int t_ = fr | (fq << 4); asm volatile("" : "+v"(t_)); fr = t_ & 15; fq = t_ >> 4; }
    constexpr float TINY = 6.103515625e-05f;
#pragma unroll
    for (int bj = 0; bj < 2; ++bj) {
      const int cb = pn * 256 + bj * 128 + wc * 32 + 8 * fq;
#pragma unroll
      for (int ai = 0; ai < 2; ++ai)
#pragma unroll
        for (int m = 0; m < 4; ++m) {
          const int row = pm * 256 + ai * 128 + wr * 64 + m * 16 + fr;
          const h16* gp_ = Gt + (size_t)row * 3072 + cb;
          const h16x8 gnum = __builtin_nontemporal_load((const h16x8*)(gp_ + pass * D));
          h16x8 gden;
          if (pass < 2) gden = __builtin_nontemporal_load((const h16x8*)(gp_ + (pass + 1) * D));
          h16x8 o;
#pragma unroll
          for (int n = 0; n < 2; ++n)
#pragma unroll
            for (int e = 0; e < 4; ++e) {
              float num = (float)gnum[4 * n + e];
              if (pass > 0) num = fmaxf(num, TINY);
              float f = num;
              if (pass < 2) f = num * __builtin_amdgcn_rcpf(fmaxf((float)gden[4 * n + e], TINY));
              const float v = acc[ai][bj][m][n][e] * f;
              acc[ai][bj][m][n][e] = v;
              o[4 * n + e] = (h16)v;
            }
          if (pass == 2) *(h16x8*)(MG + (size_t)row * D + cb) = o;
        }
    }
  }
};
struct EpiIn {       static constexpr bool FUSED = false, BRANCH = false;
  unsigned char* ws; float* out; const float* bin; int l;
  __device__ __forceinline__ void operator()(const f32x4 (&acc)[2][2][4][2], int pm, int pn, int wr, int wc, int fr, int fq) const {
    { int t_ = fr | (fq << 4); asm volatile("" : "+v"(t_)); fr = t_ & 15; fq = t_ >> 4; }
    const int brow = pm * 256;
    const bool sample = brow >= MP;
    const int sb = sample ? ((brow - MP) >> 11) : (brow >> 8);
    const int pos0 = sample ? ((brow - MP) & 2047) : 0;
    if (pn < 4) {
      const bool isq = pn < 2;
      const int sec = isq ? 0 : 512;
      h16* Qb = (h16*)(ws + OFF_Q);
      h16* Kdst = sample ? ((h16*)(ws + OFF_KS) + ((size_t)sb * 2560 + 512 + pos0) * 512) : ((h16*)(ws + OFF_KP) + (size_t)sb * 256 * 512);
      const float qs = isq ? (0.125f * 1.4426950408889634f) : 1.f;
      float invf[4];
#pragma unroll
      for (int e = 0; e < 4; ++e) invf[e] = __builtin_amdgcn_exp2f(-(float)(4 * fq + e) * (13.287712379549449f / 16.f));
#pragma unroll
      for (int bj = 0; bj < 2; ++bj) {
        const int c0 = pn * 256 - sec + bj * 128 + wc * 32 + 4 * fq;
        const f32x4 b1 = *(const f32x4*)(bin + sec + c0), b2 = *(const f32x4*)(bin + sec + c0 + 16);
#pragma unroll
        for (int ai = 0; ai < 2; ++ai)
#pragma unroll
          for (int m = 0; m < 4; ++m) {
            const int rl = ai * 128 + wr * 64 + m * 16 + fr;
            f32x4 x1 = acc[ai][bj][m][0] + b1, x2 = acc[ai][bj][m][1] + b2;
            if (!isq && !sample) {
              float* ok = out + OUT_K + ((size_t)(sb * 4 + l) * 256 + rl) * 512 + c0;
              *(f32x4*)ok = x1; *(f32x4*)(ok + 16) = x2;
            }
            if (sample) {
              const int pos = pos0 + rl;
              const float pp = (float)((wc & 1) ? (pos & 63) : (pos >> 6));
#pragma unroll
              for (int e = 0; e < 4; ++e) {
                const float ang = pp * invf[e];
                const float cs = __cosf(ang), sn = __sinf(ang);
                const float y1 = x1[e] * cs - x2[e] * sn, y2 = x2[e] * cs + x1[e] * sn;
                x1[e] = y1; x2[e] = y2;
              }
            }
            h16x4 o1, o2;
#pragma unroll
            for (int e = 0; e < 4; ++e) { o1[e] = (h16)(x1[e] * qs); o2[e] = (h16)(x2[e] * qs); }
            h16* d = isq ? (Qb + (size_t)(brow + rl) * 512 + c0) : (Kdst + (size_t)rl * 512 + c0);
            *(h16x4*)d = o1; *(h16x4*)(d + 16) = o2;
          }
      }
    } else if (pn < 6) {
      const int S = sample ? 2560 : 256;
      h16* Vt = sample ? ((h16*)(ws + OFF_VTS) + (size_t)sb * 4 * 128 * 2560 + 512 + pos0) : ((h16*)(ws + OFF_VTP) + (size_t)sb * 4 * 128 * 256);
#pragma unroll
      for (int bj = 0; bj < 2; ++bj)
#pragma unroll
        for (int n = 0; n < 2; ++n) {
          const int vc = pn * 256 - 1024 + bj * 128 + wc * 32 + 8 * fq + 4 * n;
          const f32x4 bb = *(const f32x4*)(bin + 1024 + vc);
#pragma unroll
          for (int ai = 0; ai < 2; ++ai)
#pragma unroll
            for (int m = 0; m < 4; ++m) {
              const int rl = ai * 128 + wr * 64 + m * 16 + fr;
              const f32x4 v = acc[ai][bj][m][n] + bb;
              if (!sample) *(f32x4*)(out + OUT_V + ((size_t)(sb * 4 + l) * 256 + rl) * 512 + vc) = v;
#pragma unroll
              for (int e = 0; e < 4; ++e) Vt[(size_t)(vc + e) * S + rl] = (h16)v[e];
            }
        }
    } else if (pn < 8) {
      h16* U = (h16*)(ws + OFF_U);
      const int ac = (pn - 6) * 128 + wc * 32 + 8 * fq;
      f32x4 ba[2], bg[2];
#pragma unroll
      for (int n = 0; n < 2; ++n) { ba[n] = *(const f32x4*)(bin + 1536 + ac + 4 * n); bg[n] = *(const f32x4*)(bin + 1536 + 256 + ac + 4 * n); }
#pragma unroll
      for (int ai = 0; ai < 2; ++ai)
#pragma unroll
        for (int m = 0; m < 4; ++m) {
          const int row = brow + ai * 128 + wr * 64 + m * 16 + fr;
          h16x8 o;
#pragma unroll
          for (int n = 0; n < 2; ++n)
#pragma unroll
            for (int e = 0; e < 4; ++e) { const float a = acc[ai][0][m][n][e] + ba[n][e], g = acc[ai][1][m][n][e] + bg[n][e]; o[4 * n + e] = (h16)(a * sigmoidf_(g)); }
          *(h16x8*)(U + (size_t)row * 256 + ac) = o;
        }
    } else {
      const bool isg = pn >= 9;
      h16* dst = isg ? (h16*)(ws + OFF_ACT) : (h16*)(ws + OFF_PU);
      const int ld = isg ? 3072 : 256;
      const int secb = isg ? 2304 : 2048;
#pragma unroll
      for (int bj = 0; bj < 2; ++bj) {
        const int cc = pn * 256 - secb + bj * 128 + wc * 32 + 8 * fq;
        f32x4 bb[2];
#pragma unroll
        for (int n = 0; n < 2; ++n) bb[n] = *(const f32x4*)(bin + secb + cc + 4 * n);
#pragma unroll
        for (int ai = 0; ai < 2; ++ai)
#pragma unroll
          for (int m = 0; m < 4; ++m) {
            const int row = brow + ai * 128 + wr * 64 + m * 16 + fr;
            h16x8 o;
#pragma unroll
            for (int n = 0; n < 2; ++n)
#pragma unroll
              for (int e = 0; e < 4; ++e) { const float v = acc[ai][bj][m][n][e] + bb[n][e]; o[4 * n + e] = (h16)(isg ? sigmoidf_(v) : v); }
            *(h16x8*)(dst + (size_t)row * ld + cc) = o;
          }
      }
    }
  }
};

enum { G_UP = 0, G_DOWN = 1, G_INPROJ = 2, G_BRANCH = 3, G_OUT = 4 };

__device__ __forceinline__ void ctx_convert(const Ctx& c, int l) {
  unsigned char* ws = c.ws;
  {
    const int gt = c.bx * 512 + c.tid, ng = c.G * 512;
    const float* ck = c.in[I_CK]; const float* cv = c.in[I_CV];
    h16* KS = (h16*)(ws + OFF_KS); h16* VTS = (h16*)(ws + OFF_VTS);
    for (int i = gt; i < 8 * 512 * 128; i += ng) {
      const int b = i >> 16, rem = i & 65535, key = rem >> 7, c4 = (rem & 127) * 4;
      const float4 kv = *(const float4*)(ck + (((size_t)(b * 4 + l) * 512 + key) * 512 + c4));
      h16x4 hk; hk[0] = (h16)kv.x; hk[1] = (h16)kv.y; hk[2] = (h16)kv.z; hk[3] = (h16)kv.w;
      *(h16x4*)(KS + ((size_t)b * 2560 + key) * 512 + c4) = hk;
    }
    for (int i = gt; i < 8 * 128 * 512; i += ng) {
      const int b = i >> 16, rem = i & 65535, k4 = rem >> 9, vc = rem & 511;
      h16x4 hv;
#pragma unroll
      for (int j = 0; j < 4; ++j) hv[j] = (h16)cv[((size_t)(b * 4 + l) * 512 + k4 * 4 + j) * 512 + vc];
      *(h16x4*)(VTS + ((size_t)b * 512 + vc) * 2560 + k4 * 4) = hv;
    }
  }
}

constexpr int AT_KP = 272, AT_VP = 144, AT_KB = 64 * AT_KP, AT_VB = 128 * AT_VP, AT_BUF = AT_KB + AT_VB;

__device__ __forceinline__ void attn_qk(const unsigned char* Kl, const h16x8 (&q)[4], f32x16& s0, f32x16& s1, int kap, int mp, int hh) {
#pragma unroll
  for (int i = 0; i < 16; ++i) { s0[i] = 0.f; s1[i] = 0.f; }
  const unsigned char* kp = Kl + kap * AT_KP + (mp * 64 + hh * 8) * 2;
  h16x8 ka[2][4];
#pragma unroll
  for (int ks = 0; ks < 4; ++ks) { ka[0][ks] = *(const h16x8*)(kp + ks * 32); ka[1][ks] = *(const h16x8*)(kp + 32 * AT_KP + ks * 32); }
#pragma unroll
  for (int ks = 0; ks < 4; ++ks) {
    s0 = __builtin_amdgcn_mfma_f32_32x32x16_f16(ka[0][ks], q[ks], s0, 0, 0, 0);
    s1 = __builtin_amdgcn_mfma_f32_32x32x16_f16(ka[1][ks], q[ks], s1, 0, 0, 0);
  }
}
__device__ __forceinline__ void attn_softmax(f32x16& s0, f32x16& s1, h16x8 (&pb)[4], f32x16 (&O)[4], float& mrun, float& lsum, int lane) {
  float mx = s0[0];
#pragma unroll
  for (int i = 1; i < 16; ++i) mx = fmaxf(mx, s0[i]);
#pragma unroll
  for (int i = 0; i < 16; ++i) mx = fmaxf(mx, s1[i]);
  mx = fmaxf(mx, shx(mx, 32, lane));
  const float mnew = fmaxf(mrun, mx);
  if (__any(mnew > mrun)) {
    const float al = __builtin_amdgcn_exp2f(mrun - mnew);
    lsum *= al;
#pragma unroll
    for (int f = 0; f < 4; ++f)
#pragma unroll
      for (int i = 0; i < 16; ++i) O[f][i] *= al;
    mrun = mnew;
  }
  typedef float f32x2 __attribute__((ext_vector_type(2)));
  const f32x2 mm = {mrun, mrun};
  f32x2 ps2 = {0.f, 0.f};
#pragma unroll
  for (int i = 0; i < 8; ++i) {
    f32x2 d = (f32x2){s0[2 * i], s0[2 * i + 1]} - mm;
    d.x = __builtin_amdgcn_exp2f(d.x); d.y = __builtin_amdgcn_exp2f(d.y);
    ps2 += d; s0[2 * i] = d.x; s0[2 * i + 1] = d.y;
  }
#pragma unroll
  for (int i = 0; i < 8; ++i) {
    f32x2 d = (f32x2){s1[2 * i], s1[2 * i + 1]} - mm;
    d.x = __builtin_amdgcn_exp2f(d.x); d.y = __builtin_amdgcn_exp2f(d.y);
    ps2 += d; s1[2 * i] = d.x; s1[2 * i + 1] = d.y;
  }
  lsum += ps2.x + ps2.y;
#pragma unroll
  for (int j = 0; j < 8; ++j) { pb[0][j] = (h16)s0[j]; pb[1][j] = (h16)s0[8 + j]; pb[2][j] = (h16)s1[j]; pb[3][j] = (h16)s1[8 + j]; }
}
__device__ __forceinline__ void attn_pv(const unsigned char* Vl, const h16x8 (&pb)[4], f32x16 (&O)[4], int r, int hh) {
  const unsigned char* vp = Vl + r * AT_VP + hh * 16;
  h16x8 va[4], vb[4];
#pragma unroll
  for (int f = 0; f < 4; ++f) va[f] = *(const h16x8*)(vp + f * 32 * AT_VP);
#pragma unroll
  for (int f = 0; f < 4; ++f) vb[f] = *(const h16x8*)(vp + f * 32 * AT_VP + 32);
#pragma unroll
  for (int f = 0; f < 4; ++f) O[f] = __builtin_amdgcn_mfma_f32_32x32x16_f16(va[f], pb[0], O[f], 0, 0, 0);
#pragma unroll
  for (int f = 0; f < 4; ++f) va[f] = *(const h16x8*)(vp + f * 32 * AT_VP + 64);
#pragma unroll
  for (int f = 0; f < 4; ++f) O[f] = __builtin_amdgcn_mfma_f32_32x32x16_f16(vb[f], pb[1], O[f], 0, 0, 0);
#pragma unroll
  for (int f = 0; f < 4; ++f) vb[f] = *(const h16x8*)(vp + f * 32 * AT_VP + 96);
#pragma unroll
  for (int f = 0; f < 4; ++f) O[f] = __builtin_amdgcn_mfma_f32_32x32x16_f16(va[f], pb[2], O[f], 0, 0, 0);
#pragma unroll
  for (int f = 0; f < 4; ++f) O[f] = __builtin_amdgcn_mfma_f32_32x32x16_f16(vb[f], pb[3], O[f], 0, 0, 0);
}

__device__ __forceinline__ void attn_item(const Ctx& c, int l, int item, float lam, float post) {
  unsigned char* ws = c.ws; unsigned char* lds = c.lds;
  const bool sample = item < 512;
  int b, h, qb, S, tok0; const h16* Kb; const h16* Vt;
  if (sample) { b = item >> 6; h = (item >> 4) & 3; qb = item & 15; S = 2560; tok0 = MP + b * 2048 + qb * 128;
                Kb = (const h16*)(ws + OFF_KS) + (size_t)b * 2560 * 512 + h * 128; Vt = (const h16*)(ws + OFF_VTS) + (size_t)(b * 4 + h) * 128 * 2560; }
  else { const int it = item - 512; b = it >> 3; h = (it >> 1) & 3; qb = it & 1; S = 256; tok0 = b * 256 + qb * 128;
         Kb = (const h16*)(ws + OFF_KP) + (size_t)b * 256 * 512 + h * 128; Vt = (const h16*)(ws + OFF_VTP) + (size_t)(b * 4 + h) * 128 * 256; }
  const int w = CWAVE, mp = w >> 2, qg = w & 3, r = CLANE & 31, hh = CLANE >> 5;
  const int kap = (r & ~12) | ((r & 4) << 1) | ((r & 8) >> 1);
  const h16* Qp = (const h16*)(ws + OFF_Q) + (size_t)(tok0 + qg * 32 + r) * 512 + h * 128 + mp * 64 + hh * 8;
  h16x8 q[4];
#pragma unroll
  for (int ks = 0; ks < 4; ++ks) q[ks] = *(const h16x8*)(Qp + ks * 16);
  f32x16 O[4];
#pragma unroll
  for (int f = 0; f < 4; ++f)
#pragma unroll
    for (int i = 0; i < 16; ++i) O[f][i] = 0.f;
  float mrun = -1e30f, lsum = 0.f;
  const int nT = S >> 6;
  const int t0r = sample ? (qb * 5) >> 1 : qb * 2;
#define TILE(t) (((t) + t0r) >= nT ? ((t) + t0r - nT) : ((t) + t0r))
  const int kr0 = c.tid >> 4, kc = c.tid & 15;
  const int ve0 = c.tid >> 3, vch = c.tid & 7;
  const h16* kg = Kb + (size_t)kr0 * 512 + kc * 8;
  const h16* vg = Vt + (size_t)ve0 * S + vch * 8;
  unsigned char* kl0 = lds + kr0 * AT_KP + kc * 16;
  unsigned char* vl0 = lds + AT_KB + ve0 * AT_VP + vch * 16;
  h16x8 kA[2], vA[2];
#define AT_LOAD(t) do { _Pragma("unroll") for (int i_ = 0; i_ < 2; ++i_) { \
    kA[i_] = *(const h16x8*)(kg + (size_t)((t) * 64 + i_ * 32) * 512); vA[i_] = *(const h16x8*)(vg + (size_t)(i_ * 64) * S + (t) * 64); } } while (0)
#define AT_WRITE(boff) do { _Pragma("unroll") for (int i_ = 0; i_ < 2; ++i_) { \
    *(h16x8*)(kl0 + (boff) + i_ * 32 * AT_KP) = kA[i_]; *(h16x8*)(vl0 + (boff) + i_ * 64 * AT_VP) = vA[i_]; } } while (0)
  {
    h16x8 kB[2], vB[2], kC[2], vC[2];
#pragma unroll
    for (int i_ = 0; i_ < 2; ++i_) {
      kA[i_] = *(const h16x8*)(kg + (size_t)(TILE(0) * 64 + i_ * 32) * 512);  vA[i_] = *(const h16x8*)(vg + (size_t)(i_ * 64) * S + TILE(0) * 64);
      kB[i_] = *(const h16x8*)(kg + (size_t)(TILE(1) * 64 + i_ * 32) * 512);  vB[i_] = *(const h16x8*)(vg + (size_t)(i_ * 64) * S + TILE(1) * 64);
      kC[i_] = *(const h16x8*)(kg + (size_t)(TILE(2) * 64 + i_ * 32) * 512);  vC[i_] = *(const h16x8*)(vg + (size_t)(i_ * 64) * S + TILE(2) * 64);
    }
    AT_WRITE(0);
#pragma unroll
    for (int i_ = 0; i_ < 2; ++i_) { *(h16x8*)(kl0 + AT_BUF + i_ * 32 * AT_KP) = kB[i_]; *(h16x8*)(vl0 + AT_BUF + i_ * 64 * AT_VP) = vB[i_]; kA[i_] = kC[i_]; vA[i_] = vC[i_]; }
  }
  __syncthreads();
  f32x16 s0, s1, n0, n1;
  attn_qk(lds, q, s0, s1, kap, mp, hh);
  int bc = 0, bn = AT_BUF, bw = 2 * AT_BUF;
  for (int kt = 0; kt < nT; ++kt) {
    if (kt + 2 < nT) AT_WRITE(bw);
    if (kt + 3 < nT) AT_LOAD(TILE(kt + 3));
    if (kt + 1 < nT) attn_qk(lds + bn, q, n0, n1, kap, mp, hh);
    __builtin_amdgcn_sched_barrier(0);
    h16x8 pb[4];
    attn_softmax(s0, s1, pb, O, mrun, lsum, CLANE);
    attn_pv(lds + bc + AT_KB, pb, O, r, hh);
    __syncthreads();
    s0 = n0; s1 = n1;
    const int t_ = bc; bc = bn; bn = bw; bw = t_;
  }
#undef AT_LOAD
#undef AT_WRITE
#undef TILE
  const float inv = 1.f / (lsum + shx(lsum, 32, CLANE));
  f32x4* ex = (f32x4*)lds;
  const float* sg = c.in[I_SUBG] + (size_t)(l * 4 + h) * 128;
  float4 gg[4][4];
  if (mp == 1) {
#pragma unroll
    for (int f = 0; f < 4; ++f)
#pragma unroll
      for (int g = 0; g < 4; ++g)
        ex[((qg * 4 + f) * 4 + g) * 64 + CLANE] = (f32x4){O[f][4 * g + 0], O[f][4 * g + 1], O[f][4 * g + 2], O[f][4 * g + 3]} * inv;
  } else {
#pragma unroll
    for (int f = 0; f < 4; ++f)
#pragma unroll
      for (int g = 0; g < 4; ++g) gg[f][g] = *(const float4*)(sg + f * 32 + 8 * g + 4 * hh);
  }
  __syncthreads();
  if (mp == 0) {
    float ss = 0.f;
#pragma unroll
    for (int f = 0; f < 4; ++f)
#pragma unroll
      for (int g = 0; g < 4; ++g) {
        const f32x4 e4 = ex[((qg * 4 + f) * 4 + g) * 64 + CLANE];
#pragma unroll
        for (int j = 0; j < 4; ++j) { const float o = O[f][4 * g + j] * inv - lam * e4[j]; O[f][4 * g + j] = o; ss += o * o; }
      }
    ss += shx(ss, 32, CLANE);
    const float rs = rsqrtf(ss * (1.f / 128.f) + LN_EPS) * post;
    h16* Od = (h16*)(ws + OFF_OATT) + (size_t)(h >> 1) * MT * 256 + (size_t)(tok0 + qg * 32 + r) * 256 + (h & 1) * 128;
#pragma unroll
    for (int f = 0; f < 4; ++f)
#pragma unroll
      for (int g = 0; g < 4; ++g) {
        const int e0 = f * 32 + 8 * g + 4 * hh;
        h16x4 pk;
        pk[0] = (h16)(O[f][4 * g + 0] * rs * gg[f][g].x); pk[1] = (h16)(O[f][4 * g + 1] * rs * gg[f][g].y);
        pk[2] = (h16)(O[f][4 * g + 2] * rs * gg[f][g].z); pk[3] = (h16)(O[f][4 * g + 3] * rs * gg[f][g].w);
        *(h16x4*)(Od + e0) = pk;
      }
  }
  __syncthreads();
}

__device__ __forceinline__ void mix_phase(const Ctx& c, int l) {
  unsigned char* ws = c.ws;
  {
    const float* lq = c.in[I_LAM] + (size_t)l * 256;
    const float d1 = wave_sum(lq[CLANE] * lq[64 + CLANE], CLANE);
    const float d2 = wave_sum(lq[128 + CLANE] * lq[192 + CLANE], CLANE);
    const float lam_init = 0.8f - 0.6f * expf(-0.3f * (float)l);
    const float lam = expf(d1) - expf(d2) + lam_init;
    const int G = c.G, bx = c.bx;
    const int lid = (G % 8 == 0) ? (bx % 8) * (G / 8) + bx / 8 : bx;
    for (int item = lid; item < 768; item += G) attn_item(c, l, item, lam, 1.f - lam_init);
  }
  const int gw = c.bx * 8 + CWAVE, nw = c.G * 8;
  {
    const h16* U = (const h16*)(ws + OFF_U);
    h16* UC = (h16*)(ws + OFF_UC);
    const float* cw = c.in[I_CDW] + (size_t)l * 31 * 256 + CLANE * 4;
    float4 wv[31];
#pragma unroll
    for (int k = 0; k < 31; ++k) wv[k] = *(const float4*)(cw + k * 256);
    const float4 cb = *(const float4*)(c.in[I_CDB] + l * 256 + CLANE * 4);
    const float4 lg = *(const float4*)(c.in[I_CLG] + l * 256 + CLANE * 4);
    const float4 lb = *(const float4*)(c.in[I_CLB] + l * 256 + CLANE * 4);
    for (int tb = gw * 4; tb < MT; tb += nw * 4) {
      const int sbeg = tb < MP ? (tb & ~255) : MP + ((tb - MP) & ~2047);
      const int send = tb < MP ? sbeg + 256 : sbeg + 2048;
      h16x4 row[34];
#pragma unroll
      for (int r = 0; r < 34; ++r) {
        const int g = tb - 15 + r;
        const bool ok = (g >= sbeg && g < send);
        row[r] = *(const h16x4*)(U + (size_t)(ok ? g : tb) * 256 + CLANE * 4);
        if (!ok) { row[r][0] = (h16)0.f; row[r][1] = (h16)0.f; row[r][2] = (h16)0.f; row[r][3] = (h16)0.f; }
      }
      float4 a[4];
#pragma unroll
      for (int i = 0; i < 4; ++i) a[i] = cb;
#pragma unroll
      for (int k = 0; k < 31; ++k)
#pragma unroll
        for (int i = 0; i < 4; ++i) {
          a[i].x += wv[k].x * (float)row[i + k][0]; a[i].y += wv[k].y * (float)row[i + k][1]; a[i].z += wv[k].z * (float)row[i + k][2]; a[i].w += wv[k].w * (float)row[i + k][3];
        }
      float sm[4], sq[4];
#pragma unroll
      for (int i = 0; i < 4; ++i) sm[i] = a[i].x + a[i].y + a[i].z + a[i].w;
#pragma unroll
      for (int o = 32; o >= 1; o >>= 1)
#pragma unroll
        for (int i = 0; i < 4; ++i) sm[i] += shx(sm[i], o, CLANE);
#pragma unroll
      for (int i = 0; i < 4; ++i) {
        const float mean = sm[i] * (1.f / 256.f);
        a[i].x -= mean; a[i].y -= mean; a[i].z -= mean; a[i].w -= mean;
        sq[i] = a[i].x * a[i].x + a[i].y * a[i].y + a[i].z * a[i].z + a[i].w * a[i].w;
      }
#pragma unroll
      for (int o = 32; o >= 1; o >>= 1)
#pragma unroll
        for (int i = 0; i < 4; ++i) sq[i] += shx(sq[i], o, CLANE);
#pragma unroll
      for (int i = 0; i < 4; ++i) {
        const float rstd = rsqrtf(sq[i] * (1.f / 256.f) + LN_EPS);
        const float y0 = a[i].x * rstd * lg.x + lb.x, y1 = a[i].y * rstd * lg.y + lb.y, y2 = a[i].z * rstd * lg.z + lb.z, y3 = a[i].w * rstd * lg.w + lb.w;
        h16x4 o; o[0] = (h16)(y0 * sigmoidf_(y0)); o[1] = (h16)(y1 * sigmoidf_(y1)); o[2] = (h16)(y2 * sigmoidf_(y2)); o[3] = (h16)(y3 * sigmoidf_(y3));
        *(h16x4*)(UC + (size_t)(tb + i) * 256 + CLANE * 4) = o;
      }
    }
  }
  {
    const h16* PU = (const h16*)(ws + OFF_PU);
    h16* PL = (h16*)(ws + OFF_PL);
    const int hw = 1 << (CLANE >> 4);
    float wm[16];
#pragma unroll
    for (int k = -8; k < 8; ++k) wm[k + 8] = (k >= -hw && k < hw) ? 1.f : 0.f;
    for (int tb = gw * 4; tb < MT; tb += nw * 4) {
      const int sbeg = tb < MP ? (tb & ~255) : MP + ((tb - MP) & ~2047);
      const int L = tb < MP ? 256 : 2048, send = sbeg + L;
      h16x4 row[19];
#pragma unroll
      for (int r = 0; r < 19; ++r) {
        const int g = tb - 8 + r;
        const bool ok = (g >= sbeg && g < send);
        row[r] = *(const h16x4*)(PU + (size_t)(ok ? g : tb) * 256 + CLANE * 4);
        if (!ok) { row[r][0] = (h16)0.f; row[r][1] = (h16)0.f; row[r][2] = (h16)0.f; row[r][3] = (h16)0.f; }
      }
#pragma unroll
      for (int i = 0; i < 4; ++i) {
        float s0 = 0.f, s1 = 0.f, s2 = 0.f, s3 = 0.f;
#pragma unroll
        for (int k = 0; k < 16; ++k) { s0 += wm[k] * (float)row[i + k][0]; s1 += wm[k] * (float)row[i + k][1]; s2 += wm[k] * (float)row[i + k][2]; s3 += wm[k] * (float)row[i + k][3]; }
        const int pos = tb + i - sbeg;
        const int lo = max(pos - hw, 0), hi = min(pos + hw, L);
        const float rc = 1.f / (float)(hi - lo);
        const h16x4 u = row[i + 8];
        h16x4 o; o[0] = (h16)(s0 * rc - (float)u[0]); o[1] = (h16)(s1 * rc - (float)u[1]); o[2] = (h16)(s2 * rc - (float)u[2]); o[3] = (h16)(s3 * rc - (float)u[3]);
        *(h16x4*)(PL + (size_t)(tb + i) * 256 + CLANE * 4) = o;
      }
    }
  }
}

__device__ __forceinline__ void convert_tile(const Ctx& c, const float* __restrict__ src, int K, int N, h16* __restrict__ dst, int perm, int tile) {
  float* T = (float*)c.lds;
  const int nNt = N >> 8, kt = tile / nNt, nt = tile % nNt, k0 = kt * 64, n0 = nt * 256;
  {
    const int tx = c.tid & 63, ty = c.tid >> 6;
    float4 v[8];
#pragma unroll
    for (int i = 0; i < 8; ++i) v[i] = *(const float4*)(src + (size_t)(k0 + ty * 8 + i) * N + n0 + tx * 4);
#pragma unroll
    for (int i = 0; i < 8; ++i) { float* t = T + (ty * 8 + i) * 257 + tx * 4; t[0] = v[i].x; t[1] = v[i].y; t[2] = v[i].z; t[3] = v[i].w; }
  }
  __syncthreads();
  {
    const int n = c.tid >> 1, kh = c.tid & 1;
    int nn = n0 + n;
    if (perm == 1) {
      if (nn < DFF) nn = (nn >> 7) * 256 + (nn & 127); else { const int j = nn - DFF; nn = (j >> 7) * 256 + 128 + (j & 127); }
    } else if (perm == 2) {
      if (nn >= 1536 && nn < 2048) { const int q = nn - 1536; if (q < 256) nn = 1536 + (q >> 7) * 256 + (q & 127); else { const int j = q - 256; nn = 1536 + (j >> 7) * 256 + 128 + (j & 127); } }
    }
    if (!(perm == 2 && nn < 1024)) { const int ci = nn & 31; nn = (nn & ~31) + 16 * ((ci >> 2) & 1) + 4 * (ci >> 3) + (ci & 3); }
#pragma unroll
    for (int jv = 0; jv < 4; ++jv) {
      h16x8 o;
#pragma unroll
      for (int i = 0; i < 8; ++i) o[i] = (h16)T[(kh * 32 + jv * 8 + i) * 257 + n];
      *(h16x8*)(dst + (size_t)nn * K + k0 + kh * 32 + jv * 8) = o;
    }
  }
  __syncthreads();
}

constexpr int LAYER_TILES = 2 * 352 + 2 * 176 + 336 + 32 + 16 + 64;
__device__ __forceinline__ void convert_layer_tile(const Ctx& c, int l, int q) {
  unsigned char* ws = c.ws;
  if (q < 704)       { const int mi = l * 2 + q / 352; convert_tile(c, c.in[I_WFIN] + (size_t)mi * D * NUP, D, NUP, (h16*)(ws + OFF_WUP) + (size_t)mi * NUP * D, 1, q % 352); }
  else if (q < 1056) { q -= 704; const int mi = l * 2 + q / 176; convert_tile(c, c.in[I_WFOUT] + (size_t)mi * DFF * D, DFF, D, (h16*)(ws + OFF_WDN) + (size_t)mi * D * DFF, 0, q % 176); }
  else if (q < 1392) { q -= 1056; convert_tile(c, c.in[I_WIN] + (size_t)l * D * INC, D, INC, (h16*)(ws + OFF_WIN) + (size_t)l * INC * D, 2, q); }
  else if (q < 1424) { q -= 1392; const int mi = l * 2 + q / 16; convert_tile(c, c.in[I_WATT] + (size_t)mi * 256 * D, 256, D, (h16*)(ws + OFF_WATT) + (size_t)mi * D * 256, 0, q % 16); }
  else if (q < 1440) { q -= 1424; convert_tile(c, c.in[I_WCONV] + (size_t)l * 256 * D, 256, D, (h16*)(ws + OFF_WCONV) + (size_t)l * D * 256, 0, q); }
  else               { q -= 1440; convert_tile(c, c.in[I_WOUT] + (size_t)l * D * D, D, D, (h16*)(ws + OFF_WOUT) + (size_t)l * D * D, 0, q); }
}

__device__ __forceinline__ void phase0(const Ctx& c) {
  unsigned char* ws = c.ws;
  const int G = c.G;
  constexpr int N_MOD_IT = 144, N_POOL_IT = 256;
  constexpr int TOTAL = N_MOD_IT + N_POOL_IT + LAYER_TILES;
  const bool w256 = (G == 256);
  const int nsh = w256 ? 592 : G, sh0 = w256 ? (c.bx < 144 ? c.bx : 144 + 4 * (c.bx - 144)) : c.bx, nown = (w256 && c.bx >= 144) ? 4 : 1;
  const int n_other = TOTAL - N_MOD_IT;
  int vi = 0, j = sh0;
  bool mod_pending = c.bx < N_MOD_IT;
  int mod_it = c.bx;
  for (;;) {
    int it;
    if (mod_pending) { it = mod_it; mod_it += G; mod_pending = w256 ? false : (mod_it < N_MOD_IT); }
    else {
      while (vi < nown && j >= n_other) { ++vi; j = sh0 + vi; }
      if (vi >= nown) break;
      it = N_MOD_IT + j; j += nsh;
    }
    if (it < N_MOD_IT) {
      float* sc = (float*)c.lds;
      float* red = sc + 12 * 1024;
      for (int i = c.tid; i < 9 * 1024; i += 512) {
        const float x = (i < 1024) ? c.in[I_CCTX][i] : c.in[I_C][i - 1024];
        sc[(i & 1023) * 12 + (i >> 10)] = x * sigmoidf_(x);
      }
      __syncthreads();
      const int l = it / 36, cb = (it % 36) * 256;
      const float* wp = c.in[I_WMOD] + ((size_t)l * 1024 + CWAVE * 128) * NMODC + cb + CLANE * 4;
      float4 a[9];
#pragma unroll
      for (int r = 0; r < 9; ++r) a[r] = make_float4(0.f, 0.f, 0.f, 0.f);
      for (int k0 = 0; k0 < 128; k0 += 8) {
        float4 w4[8];
#pragma unroll
        for (int kk = 0; kk < 8; ++kk) w4[kk] = *(const float4*)(wp + (size_t)(k0 + kk) * NMODC);
#pragma unroll
        for (int kk = 0; kk < 8; ++kk) {
          const float* sp = sc + (CWAVE * 128 + k0 + kk) * 12;
          const float4 s0 = *(const float4*)sp, s1 = *(const float4*)(sp + 4); const float s8 = sp[8];
          const float sv[9] = {s0.x, s0.y, s0.z, s0.w, s1.x, s1.y, s1.z, s1.w, s8};
#pragma unroll
          for (int r = 0; r < 9; ++r) { a[r].x += sv[r] * w4[kk].x; a[r].y += sv[r] * w4[kk].y; a[r].z += sv[r] * w4[kk].z; a[r].w += sv[r] * w4[kk].w; }
        }
      }
#pragma unroll
      for (int r = 0; r < 9; ++r) *(float4*)(red + (CWAVE * 9 + r) * 256 + CLANE * 4) = a[r];
      __syncthreads();
      float* MOD = (float*)(ws + OFF_MOD);
      for (int i = c.tid; i < 9 * 256; i += 512) {
        const int r = i >> 8, cc = i & 255;
        float s = c.in[I_BMOD][(size_t)l * NMODC + cb + cc];
#pragma unroll
        for (int w = 0; w < 8; ++w) s += red[(w * 9 + r) * 256 + cc];
        MOD[(size_t)(r * 4 + l) * NMODC + cb + cc] = s;
      }
      __syncthreads();
    } else if (it < N_MOD_IT + N_POOL_IT) {
      const int q = it - N_MOD_IT, l = q >> 6, nch = (q >> 2) & 15, g = q & 3;
      float* wg = (float*)c.lds;
      float* wo = wg + 64 * 65;
      const float* wgp = c.in[I_WPG] + (size_t)(l * 4 + g) * 4096;
      const float* scp = c.in[I_PSC] + l * 256 + g * 64;
      const float* wop = c.in[I_WPO] + ((size_t)l * 256 + g * 64) * D + nch * 64;
      for (int i = c.tid; i < 4096; i += 512) {
        const int a = i >> 6, b2 = i & 63;
        wg[a * 65 + b2] = wgp[i] * scp[b2];
        wo[i] = wop[(size_t)a * D + b2];
      }
      __syncthreads();
      h16* dst = (h16*)(ws + OFF_WPOOL) + (size_t)l * D * 256;
      const int n = c.tid & 63;
#pragma unroll
      for (int i = 0; i < 8; ++i) {
        const int cil = (c.tid >> 6) * 8 + i;
        float s = 0.f;
        for (int co = 0; co < 64; ++co) s += wg[cil * 65 + co] * wo[co * 64 + n];
        const int nf = nch * 64 + n, ci = nf & 31, np = (nf & ~31) + 16 * ((ci >> 2) & 1) + 4 * (ci >> 3) + (ci & 3);
        dst[(size_t)np * 256 + g * 64 + cil] = (h16)s;
      }
      __syncthreads();
    } else {
      convert_layer_tile(c, 0, it - N_MOD_IT - N_POOL_IT);
    }
  }
}

__device__ __forceinline__ void phase0b(const Ctx& c) {
  const float* MOD = (const float*)(c.ws + OFF_MOD);
  h16* H = (h16*)(c.ws + OFF_H);
  const int gt = c.bx * 512 + c.tid, ng = c.G * 512;
  for (int i = gt; i < MT * (D / 4); i += ng) {
    const int row = i >> 8, c4 = (i & 255) * 4;
    const float* src = (row < MP) ? (c.in[I_XP] + (size_t)row * D) : (c.in[I_XS] + (size_t)(row - MP) * D);
    const float4 x = *(const float4*)(src + c4);
    const float* md = MOD + (size_t)(cond_row(row) * 4) * NMODC;
    const float4 sh = *(const float4*)(md + c4), sc = *(const float4*)(md + D + c4);
    h16x4 hv; hv[0] = (h16)(x.x * (1.f + sc.x) + sh.x); hv[1] = (h16)(x.y * (1.f + sc.y) + sh.y);
    hv[2] = (h16)(x.z * (1.f + sc.z) + sh.z); hv[3] = (h16)(x.w * (1.f + sc.w) + sh.w);
    *(h16x4*)(H + (size_t)row * D + c4) = hv;
  }
}

__device__ __forceinline__ void grid_bar(unsigned* w, unsigned gen, int tid, unsigned bx, unsigned G) {
  asm volatile("s_waitcnt vmcnt(0)" ::: "memory");
  __syncthreads();
  if (tid == 0) {
    __builtin_amdgcn_fence(__ATOMIC_RELEASE, "agent");
    asm volatile("s_waitcnt vmcnt(0)" ::: "memory");
    const unsigned g = bx & 7u, gsz = (G - g + 7u) >> 3, ngr = G < 8u ? G : 8u;
    const unsigned old = __hip_atomic_fetch_add(w + 64 * g, 1u, __ATOMIC_RELAXED, __HIP_MEMORY_SCOPE_AGENT);
    if (old == gen * gsz - 1u) {
      const unsigned t = __hip_atomic_fetch_add(w + 512, 1u, __ATOMIC_RELAXED, __HIP_MEMORY_SCOPE_AGENT);
      if (t == gen * ngr - 1u) __hip_atomic_store(w + 576, gen, __ATOMIC_RELAXED, __HIP_MEMORY_SCOPE_AGENT);
    }
    while (__hip_atomic_load(w + 576, __ATOMIC_RELAXED, __HIP_MEMORY_SCOPE_AGENT) < gen) __builtin_amdgcn_s_sleep(1);
    __builtin_amdgcn_fence(__ATOMIC_ACQUIRE, "agent");
    asm volatile("s_waitcnt vmcnt(0)" ::: "memory");
  }
  __syncthreads();
}

__global__ void __launch_bounds__(512, 2) fwd_kernel(Params p) {
  extern __shared__ __attribute__((aligned(16))) unsigned char lds[];
  cg::grid_group grid = cg::this_grid();
  for (int step = 0; step < 34; ++step) {
    int tid_ = threadIdx.x; asm volatile("" : "+v"(tid_));
    unsigned z_; asm volatile("s_mov_b32 %0, 0" : "=s"(z_));
    typedef const Params __attribute__((address_space(4))) CParams;
    CParams* kp = (CParams*)((const char __attribute__((address_space(4)))*)__builtin_amdgcn_kernarg_segment_ptr() + z_);
    unsigned char* ws_ = kp->ws;
    float* out_ = kp->out;
    InTab in_ = kp->in;
    int bx_ = blockIdx.x, G_ = gridDim.x; asm volatile("" : "+s"(bx_), "+s"(G_));
    Ctx c; c.bx = bx_; c.G = G_; c.in = in_; c.out = out_; c.ws = ws_; c.lds = lds; c.tid = tid_;
    if (step == 0) phase0(c);
    else if (step == 1) phase0b(c);
    else {
      const int l = (step - 2) >> 3, s = (step - 2) & 7;
      if (s == 3) mix_phase(c, l);
      else {
        LAS unsigned char* L3 = (LAS unsigned char*)lds;
        unsigned char* ws = c.ws;
        const float* MOD = (const float*)(ws + OFF_MOD);
        if (s == 0 || s == 6) {
          EpiUp E{(h16*)(ws + OFF_ACT)};
          gemm_stream(c.tid, c.bx, c.G, L3, (const h16*)(ws + OFF_H), (const h16*)(ws + OFF_WUP) + (size_t)(l * 2 + (s == 6)) * NUP * D, NUP, D, E);
        } else if (s == 1 || s == 5 || s == 7) {
          EpiResLn E{ws, c.in, c.out, l, s};
          if (s == 5) gemm_stream(c.tid, c.bx, c.G, L3, (const h16*)(ws + OFF_MG), (const h16*)(ws + OFF_WOUT) + (size_t)l * D * D, D, D, E);
          else {
            gemm_stream(c.tid, c.bx, c.G, L3, (const h16*)(ws + OFF_ACT), (const h16*)(ws + OFF_WDN) + (size_t)(l * 2 + (s == 7)) * D * DFF, D, DFF, E);
            if (l < 3) {
              const int half = (s == 7), w0 = (c.G == 256) ? c.bx - 128 : c.bx, nw = (c.G == 256) ? 128 : c.G;
              if (w0 >= 0) for (int q = half * (LAYER_TILES / 2) + w0; q < (half + 1) * (LAYER_TILES / 2); q += nw) convert_layer_tile(c, l + 1, q);
            }
          }
        } else if (s == 2) {
          EpiIn E{ws, c.out, c.in[I_BIN] + (size_t)l * INC, l};
          gemm_stream(c.tid, c.bx, c.G, L3, (const h16*)(ws + OFF_H), (const h16*)(ws + OFF_WIN) + (size_t)l * INC * D, INC, D, E);
          ctx_convert(c, l);
        } else {
          EpiBranch E{(const h16*)(ws + OFF_ACT), (h16*)(ws + OFF_MG)};
          gemm_stream(c.tid, c.bx, c.G, L3, (const h16*)ws, (const h16*)ws, D, 256, E, l);
        }
      }
    }
    if (G_ == 0x7fffffff) grid.sync();
    if (step != 33) grid_bar((unsigned*)(ws_ + WS_END), (unsigned)(step + 1), tid_, (unsigned)bx_, (unsigned)G_);
  }
}

extern "C" void kernel_launch(void* const* d_in, const int* in_sizes, int n_in, void* d_out, int out_size,
                              void* d_ws, size_t ws_size, hipStream_t stream) {
  static int grid_blocks = 0;
  if (!grid_blocks) {
    int dev = 0, cus = 0, per_cu = 0;
    (void)hipGetDevice(&dev);
    (void)hipDeviceGetAttribute(&cus, hipDeviceAttributeMultiprocessorCount, dev);
    (void)hipFuncSetAttribute((const void*)fwd_kernel, hipFuncAttributeMaxDynamicSharedMemorySize, LDS_BYTES);
    (void)hipOccupancyMaxActiveBlocksPerMultiprocessor(&per_cu, (const void*)fwd_kernel, 512, LDS_BYTES);
    if (per_cu < 1) fprintf(stderr, "occupancy query says %d blocks/CU\n", per_cu);
    grid_blocks = cus;
    if (ws_size < WS_END + CTL_BYTES) { fprintf(stderr, "workspace too small: %zu < %zu\n", ws_size, (size_t)WS_END); grid_blocks = -1; }
    if (n_in != 27) { fprintf(stderr, "expected 27 inputs, got %d\n", n_in); grid_blocks = -1; }
  }
  if (grid_blocks < 0) return;
  (void)hipMemsetAsync((unsigned char*)d_ws + WS_END, 0, CTL_BYTES, stream);
  Params p{};
  for (int i = 0; i < 27; ++i) p.in[i] = (const float*)d_in[i];
  p.out = (float*)d_out; p.ws = (unsigned char*)d_ws;
  void* args[] = {&p};
  hipError_t e = hipLaunchCooperativeKernel((const void*)fwd_kernel, dim3(grid_blocks), dim3(512), args, LDS_BYTES, stream);
  if (e != hipSuccess) fprintf(stderr, "cooperative launch failed: %s (grid %d)\n", hipGetErrorString(e), grid_blocks);
}
```

```cpp
#include <hip/hip_runtime.h>
#include <hip/hip_cooperative_groups.h>
#include <cstdio>
namespace cg = cooperative_groups;

typedef _Float16 h16;
typedef h16 h16x8 __attribute__((ext_vector_type(8)));
typedef h16 h16x4 __attribute__((ext_vector_type(4)));
typedef h16 h16x2 __attribute__((ext_vector_type(2)));
typedef float f32x4 __attribute__((ext_vector_type(4)));
typedef float f32x16 __attribute__((ext_vector_type(16)));

constexpr int D = 1024, MT = 24576, MP = 8192, DFF = 2816, NUP = 5632, INC = 5376, NMODC = 9216;
constexpr float ALPHA = 1.681792830507429f;
constexpr float LN_EPS = 1e-5f;
constexpr size_t OUT_K = (size_t)MT * D;
constexpr size_t OUT_V = OUT_K + (size_t)32 * 4 * 256 * 512;

enum { I_XP = 0, I_XS, I_CK, I_CV, I_C, I_CCTX, I_WMOD, I_BMOD, I_WFIN, I_WFOUT, I_LNG, I_LNB, I_WIN, I_BIN, I_LAM, I_SUBG,
       I_WATT, I_CDW, I_CDB, I_CLG, I_CLB, I_WCONV, I_WPG, I_PSC, I_WPO, I_WOUT, I_BOUT };

constexpr size_t SZ_WUP = (size_t)4 * 2 * NUP * D * 2, SZ_WDN = (size_t)4 * 2 * D * DFF * 2, SZ_WIN = (size_t)4 * INC * D * 2;
constexpr size_t SZ_WATT = (size_t)4 * D * 512 * 2, SZ_WCONV = (size_t)4 * D * 256 * 2, SZ_WPOOL = SZ_WCONV, SZ_WOUT = (size_t)4 * D * D * 2;
constexpr size_t SZ_MOD = (size_t)9 * 4 * NMODC * 4, SZ_X = (size_t)MT * D * 4, SZ_H = (size_t)MT * D * 2, SZ_ACT = (size_t)MT * 3072 * 2;
constexpr size_t SZ_Q = (size_t)MT * 512 * 2, SZ_KP = (size_t)32 * 256 * 512 * 2, SZ_KS = (size_t)8 * 2560 * 512 * 2, SZ_VTP = SZ_KP, SZ_VTS = SZ_KS;
constexpr size_t SZ_U = (size_t)MT * 256 * 2;
constexpr size_t OFF_WUP = 0, OFF_WDN = OFF_WUP + SZ_WUP, OFF_WIN = OFF_WDN + SZ_WDN, OFF_WATT = OFF_WIN + SZ_WIN, OFF_WCONV = OFF_WATT + SZ_WATT,
                 OFF_WPOOL = OFF_WCONV + SZ_WCONV, OFF_WOUT = OFF_WPOOL + SZ_WPOOL, OFF_MOD = OFF_WOUT + SZ_WOUT, OFF_X = OFF_MOD + SZ_MOD,
                 OFF_H = OFF_X + SZ_X, OFF_ACT = OFF_H + SZ_H, OFF_Q = OFF_ACT + SZ_ACT, OFF_KP = OFF_Q + SZ_Q, OFF_KS = OFF_KP + SZ_KP,
                 OFF_VTP = OFF_KS + SZ_KS, OFF_VTS = OFF_VTP + SZ_VTP, OFF_U = OFF_VTS + SZ_VTS, OFF_PU = OFF_U + SZ_U, OFF_OATT = OFF_PU + SZ_U,
                 OFF_UC = OFF_OATT + SZ_Q, OFF_PL = OFF_UC + SZ_U, OFF_MG = OFF_PL + SZ_U, OFF_XB = OFF_MG + SZ_H, WS_END = OFF_XB + (size_t)96 * 256 * 4 * 8;
constexpr size_t CTL_BYTES = 4096 + (size_t)12 * 96 * 64;

constexpr int LDS_BYTES = 128 * 1024 + 10240;

struct Params { const float* in[27]; float* out; unsigned char* ws; };

typedef const float* const __attribute__((address_space(4))) * InTab;
struct Ctx {
  InTab in; float* out; unsigned char* ws; unsigned char* lds;
  int tid, bx, G;
};
#define CLANE (c.tid & 63)
#define CWAVE (__builtin_amdgcn_readfirstlane(c.tid >> 6))

__device__ __forceinline__ int cond_row(int t) { return t < MP ? 0 : 1 + ((t - MP) >> 11); }
__device__ __forceinline__ float shx(float v, int o, int lane) {
  return __int_as_float(__builtin_amdgcn_ds_bpermute((lane ^ o) << 2, __float_as_int(v)));
}
__device__ __forceinline__ float wave_sum(float v, int lane) {
#pragma unroll
  for (int o = 32; o >= 1; o >>= 1) v += shx(v, o, lane);
  return v;
}
__device__ __forceinline__ void st_wt(void* p, f32x4 v) { asm volatile("global_store_dwordx4 %0, %1, off sc1\n\ts_nop 1" :: "v"(p), "v"(v) : "memory"); }
__device__ __forceinline__ void st_wt(void* p, h16x8 v) { st_wt(p, __builtin_bit_cast(f32x4, v)); }
__device__ __forceinline__ float sigmoidf_(float x) { return __builtin_amdgcn_rcpf(1.f + __expf(-x)); }

#define LAS __attribute__((address_space(3)))
constexpr int BM = 256, BK = 64, HALF = 128, HTB = HALF * BK * 2, NXCD = 8, WGM = 8;
__device__ __forceinline__ int lds_byte(int r, int c) {
  const int st = (r >> 4) * 2 + (c >> 5), rr = r & 15, cc = c & 31, ob = rr * 64 + cc * 2;
  return st * 1024 + (ob ^ (((ob >> 9) & 1) << 5));
}
__device__ __forceinline__ void stage_rc(int b, int& R, int& C) {
  const int st = b / 1024, sb = b % 1024, swz = sb ^ (((sb >> 9) & 1) << 5);
  R = (st >> 1) * 16 + swz / 64; C = (st & 1) * 32 + (swz % 64) / 2;
}
struct Unit { int pm, pn; };
struct StaticOrder {
  int nM, nN, nwg, G, c; bool panel;
  __device__ __forceinline__ void init(int M, int N, int G_, int c_) { nM = M / BM; nN = N / BM; nwg = nM * nN; G = G_; c = c_; }
  __device__ __forceinline__ bool next(int i, Unit& u) const {
    const long L = (long)i * G + c; if (L >= nwg) return false;
    if (panel) {
      if (G == 256) { const int r = (int)(L >> 8), cc = (int)(L & 255), x = cc & 7, j = cc >> 3; u.pn = j & 3; u.pm = r == 0 ? x * 8 + (j >> 2) : 64 + x * 4 + (j >> 2); return true; }
      u.pm = (int)(L >> 2); u.pn = (int)(L & 3); return true;
    }
    int wgid = (int)L; { const int q = nwg / NXCD, r = nwg % NXCD, xcd = wgid % NXCD, off = wgid / NXCD; wgid = (xcd < r ? xcd * (q + 1) : r * (q + 1) + (xcd - r) * q) + off; }
    const int nig = WGM * nN, gid = wgid / nig, fm = gid * WGM, gsz = (nM - fm) < WGM ? (nM - fm) : WGM;
    u.pm = fm + ((wgid % nig) % gsz); u.pn = (wgid % nig) / gsz; return true;
  }
};

template <class Epi>
__device__ __forceinline__ void gemm_stream(int tid, int bx, int G, LAS unsigned char* lds, const h16* Ag, const h16* Btg, int N, int K, const Epi& E, int lsel = 0) {
  const int  wid = __builtin_amdgcn_readfirstlane(tid >> 6), lane = tid & 63, wr = wid >> 2, wc = wid & 3, fr = lane & 15, fq = lane >> 4;
  const int nt = K / BK;
  unsigned voff[2];
#pragma unroll
  for (int i = 0; i < 2; ++i) { int R, C; stage_rc(tid * 16 + i * 8192, R, C); voff[i] = (unsigned)(R * K + C) * 2u; }
  const size_t kstep = (size_t)(BK * 2);
  const size_t hstep = (size_t)HALF * K * 2;
  const size_t tstep = 2 * hstep;
  const unsigned ldsw = (unsigned)wid * 1024u;
  const int aoff = lds_byte(wr * 64 + fr, fq * 8), boff = lds_byte(wc * 32 + fr, fq * 8);
#define PG8_SA(b, h) (((b) * 2 + (h)) * HTB)
#define PG8_SB(b, h) ((4 + (b) * 2 + (h)) * HTB)
#define PG8_STAGE(bufoff, gbase) do { _Pragma("unroll") for (int _i = 0; _i < 2; ++_i) \
    __builtin_amdgcn_global_load_lds((const unsigned*)((const char*)(gbase) + voff[_i]), (LAS unsigned*)(lds + (bufoff) + ldsw + _i * 8192), 16, 0, 0); } while (0)
#define PG8_LDA(dst, b, h) do { _Pragma("unroll") for (int m = 0; m < 4; ++m) _Pragma("unroll") for (int k = 0; k < 2; ++k) dst[m][k] = *(const LAS h16x8*)(lds + PG8_SA(b, h) + aoff + m * 2048 + k * 1024); } while (0)
#define PG8_LDB(dst, b, h) do { _Pragma("unroll") for (int n = 0; n < 2; ++n) _Pragma("unroll") for (int k = 0; k < 2; ++k) dst[n][k] = *(const LAS h16x8*)(lds + PG8_SB(b, h) + boff + n * 2048 + k * 1024); } while (0)
#define PG8_MMA(ai, bj, At, Bt) do { __builtin_amdgcn_s_setprio(1); _Pragma("unroll") for (int m = 0; m < 4; ++m) _Pragma("unroll") for (int n = 0; n < 2; ++n) _Pragma("unroll") for (int k = 0; k < 2; ++k) \
    acc[ai][bj][m][n] = __builtin_amdgcn_mfma_f32_16x16x32_f16(Bt[n][k], At[m][k], acc[ai][bj][m][n], 0, 0, 0); __builtin_amdgcn_s_setprio(0); } while (0)
#define PG8_WAIT_V(n) asm volatile("s_waitcnt vmcnt(" #n ")" ::: "memory")
#define PG8_WAIT_L(n) asm volatile("s_waitcnt lgkmcnt(" #n ")" ::: "memory")
#define PG8_BAR __builtin_amdgcn_s_barrier()
#define PG8_SCHED __builtin_amdgcn_sched_barrier(0)
  StaticOrder S; S.init(MT, N, G, bx); S.panel = Epi::FUSED;
  Unit cur, nxt; int ui = 0;
  if (!S.next(0, cur)) return;
#define BR_A(sub) ((const char*)Ag + ((sub) == 0 ? OFF_OATT : (sub) == 1 ? OFF_OATT + (size_t)MT * 256 * 2 : (sub) == 2 ? OFF_UC : OFF_PL))
#define BR_B(sub) ((const char*)Ag + ((sub) < 2 ? OFF_WATT + (size_t)(lsel * 2 + (sub)) * D * 256 * 2 : ((sub) == 2 ? OFF_WCONV : OFF_WPOOL) + (size_t)lsel * D * 256 * 2))
  f32x4 acc[2][2][4][2];
#pragma unroll
  for (int a = 0; a < 2; ++a)
#pragma unroll
    for (int b = 0; b < 2; ++b)
#pragma unroll
      for (int m = 0; m < 4; ++m)
#pragma unroll
        for (int n = 0; n < 2; ++n) acc[a][b][m][n] = (f32x4){0.f, 0.f, 0.f, 0.f};
  h16x8 At[4][2], B0[2][2], B1[2][2];
  const char* cA = (Epi::BRANCH ? BR_A(0) : (const char*)Ag) + (size_t)cur.pm * tstep; const char* cB = (Epi::BRANCH ? BR_B(0) : (const char*)Btg) + (size_t)cur.pn * tstep;
  PG8_STAGE(PG8_SB(0, 0), cB); PG8_STAGE(PG8_SA(0, 0), cA); PG8_STAGE(PG8_SB(0, 1), cB + hstep); PG8_STAGE(PG8_SA(0, 1), cA + hstep);
  if (wr == 1) PG8_BAR;
  PG8_WAIT_V(4); PG8_BAR;
  PG8_STAGE(PG8_SB(1, 0), cB + kstep); PG8_STAGE(PG8_SA(1, 0), cA + kstep); PG8_STAGE(PG8_SB(1, 1), cB + hstep + kstep);
  PG8_WAIT_V(6); PG8_BAR;
  for (;;) {
    bool has_next; const char* nA; const char* nB;
    if constexpr (Epi::BRANCH) {
      const int nsub = (ui + 1) & 3;
      has_next = S.next((ui + 1) >> 2, nxt);
      nA = has_next ? BR_A(nsub) + (size_t)nxt.pm * tstep : cA; nB = has_next ? BR_B(nsub) + (size_t)nxt.pn * tstep : cB;
    } else {
      has_next = S.next(ui + 1, nxt);
      nA = has_next ? (const char*)Ag + (size_t)nxt.pm * tstep : cA; nB = has_next ? (const char*)Btg + (size_t)nxt.pn * tstep : cB;
    }
    for (int t = 0; t < nt; t += 2) {
      const bool last = (t == nt - 2);
      const char* a1 = cA + (size_t)(t + 1) * kstep;
      const char* a2 = last ? nA : cA + (size_t)(t + 2) * kstep; const char* b2 = last ? nB : cB + (size_t)(t + 2) * kstep;
      const char* a3 = a2 + kstep; const char* b3 = b2 + kstep;
      PG8_LDB(B0, 0, 0); PG8_SCHED; PG8_LDA(At, 0, 0); PG8_STAGE(PG8_SA(1, 1), a1 + hstep);
      PG8_WAIT_L(8); PG8_BAR; PG8_WAIT_L(0); PG8_MMA(0, 0, At, B0); PG8_BAR; PG8_SCHED;
      PG8_LDB(B1, 0, 1); PG8_STAGE(PG8_SB(0, 0), b2);
      PG8_BAR; PG8_WAIT_L(0); PG8_MMA(0, 1, At, B1); PG8_BAR;
      PG8_LDA(At, 0, 1); PG8_STAGE(PG8_SA(0, 0), a2);
      PG8_BAR; PG8_WAIT_L(0); PG8_MMA(1, 0, At, B0); PG8_BAR; PG8_SCHED;
      PG8_STAGE(PG8_SB(0, 1), b2 + hstep);
      PG8_WAIT_V(6); PG8_BAR; PG8_MMA(1, 1, At, B1); PG8_BAR;
      PG8_LDB(B0, 1, 0); PG8_SCHED; PG8_LDA(At, 1, 0); PG8_STAGE(PG8_SA(0, 1), a2 + hstep);
      PG8_WAIT_L(8); PG8_BAR; PG8_WAIT_L(0); PG8_MMA(0, 0, At, B0); PG8_BAR; PG8_SCHED;
      PG8_LDB(B1, 1, 1); PG8_STAGE(PG8_SB(1, 0), b3);
      PG8_BAR; PG8_WAIT_L(0); PG8_MMA(0, 1, At, B1); PG8_BAR;
      PG8_LDA(At, 1, 1); PG8_STAGE(PG8_SA(1, 0), a3);
      PG8_BAR; PG8_WAIT_L(0); PG8_MMA(1, 0, At, B0); PG8_BAR; PG8_SCHED;
      PG8_STAGE(PG8_SB(1, 1), b3 + hstep);
      PG8_WAIT_V(6); PG8_BAR; PG8_MMA(1, 1, At, B1); PG8_BAR;
    }
    if constexpr (Epi::FUSED) { if (wr == 0) PG8_BAR; E.fused(acc, cur.pm, cur.pn, wr, wc, fr, fq, lds + 131072, tid); if (wr == 1) PG8_BAR; }
    else if constexpr (Epi::BRANCH) { if ((ui & 3) != 0) E.branch(acc, cur.pm, cur.pn, wr, wc, fr, fq, (ui & 3) - 1); }
    else E(acc, cur.pm, cur.pn, wr, wc, fr, fq);
    if (!has_next) break;
    if (!(Epi::BRANCH && (ui & 3) != 3))
#pragma unroll
    for (int a = 0; a < 2; ++a)
#pragma unroll
      for (int b = 0; b < 2; ++b)
#pragma unroll
        for (int m = 0; m < 4; ++m)
#pragma unroll
          for (int n = 0; n < 2; ++n) acc[a][b][m][n] = (f32x4){0.f, 0.f, 0.f, 0.f};
    cur = nxt; cA = nA; cB = nB; ++ui;
  }
#undef BR_A
#undef BR_B
  PG8_WAIT_V(0);
  if (wr == 0) PG8_BAR;
  PG8_BAR;
#undef PG8_SA
#undef PG8_SB
#undef PG8_STAGE
#undef PG8_LDA
#undef PG8_LDB
#undef PG8_MMA
#undef PG8_WAIT_V
#undef PG8_WAIT_L
#undef PG8_BAR
#undef PG8_SCHED
}

struct EpiUp {       static constexpr bool FUSED = false, BRANCH = false;
  h16* ACT;
  __device__ __forceinline__ void operator()(const f32x4 (&acc)[2][2][4][2], int pm, int pn, int wr, int wc, int fr, int fq) const {
    { int t_ = fr | (fq << 4); asm volatile("" : "+v"(t_)); fr = t_ & 15; fq = t_ >> 4; }
#pragma unroll
    for (int ai = 0; ai < 2; ++ai)
#pragma unroll
      for (int m = 0; m < 4; ++m) {
        const int row = pm * 256 + ai * 128 + wr * 64 + m * 16 + fr;
        h16x8 o;
#pragma unroll
        for (int n = 0; n < 2; ++n)
#pragma unroll
          for (int e = 0; e < 4; ++e) { const float g = acc[ai][0][m][n][e], u = acc[ai][1][m][n][e]; o[4 * n + e] = (h16)(g * sigmoidf_(g) * u); }
        st_wt(ACT + (size_t)row * DFF + pn * 128 + wc * 32 + 8 * fq, o);
      }
  }
};
#define XBAR() do { asm volatile("s_waitcnt lgkmcnt(0)" ::: "memory"); __builtin_amdgcn_s_barrier(); asm volatile("" ::: "memory"); } while (0)
struct EpiResLn {
  static constexpr bool FUSED = true, BRANCH = false;
  unsigned char* ws; InTab in; float* out; int l, s;
  __device__ __forceinline__ void fused(f32x4 (&acc)[2][2][4][2], int pm, int pn, int wr, int wc, int fr, int fq, LAS unsigned char* lx, int tid) const {
    int l_ = l;
    asm volatile("" : "+v"(tid), "+s"(l_)); fr = tid & 15; fq = (tid >> 4) & 3;
    const int sub = (s == 1) ? 0 : (s == 5 ? 1 : 2);
    const bool first = (l_ == 0 && s == 1), last = (l_ == 3 && s == 7);
    const int lnx = (sub == 2) ? l_ + 1 : l_, inx = (sub == 2) ? 0 : sub + 1;
    const float* MOD = (const float*)(ws + OFF_MOD);
    h16* X = (h16*)(ws + OFF_X);
    const float* srcP = in[I_XP]; const float* srcS = in[I_XS] - (size_t)MP * D;
    float* dstX = out; h16* H = (h16*)(ws + OFF_H);
    const float* MODg = MOD + (size_t)l_ * NMODC + (s == 1 ? 2 : (s == 5 ? 5 : 8)) * D;
    const float* bias = (s == 5) ? in[I_BOUT] + (size_t)l_ * D : nullptr; const float coef = (s == 5) ? 1.f : 0.5f;
    const float* lng = in[I_LNG] + (size_t)(l_ * 3 + sub) * D; const float* lnb = in[I_LNB] + (size_t)(l_ * 3 + sub) * D;
    const float* MODn = last ? nullptr : MOD + (size_t)lnx * NMODC + (size_t)(3 * inx) * D;
    unsigned long long* xb = (unsigned long long*)(ws + OFF_XB); unsigned* cnt = (unsigned*)(ws + WS_END + 4096) + (size_t)(l_ * 3 + sub) * 96 * 16;
    typedef float f32x2 __attribute__((ext_vector_type(2)));
    LAS f32x2* P = (LAS f32x2*)lx;
    LAS f32x2* St = (LAS f32x2*)(lx + 8192);
    const int brow = pm * 256;
    const int crow = cond_row(brow);
    const float* gate = MODg + (size_t)crow * 4 * NMODC;
    const float* src = (brow < MP) ? srcP : srcS;
    f32x4 gt[2][2], bb[2][2];
#pragma unroll
    for (int bj = 0; bj < 2; ++bj)
#pragma unroll
      for (int n = 0; n < 2; ++n) {
        const int cb = pn * 256 + bj * 128 + wc * 32 + 8 * fq + 4 * n;
        gt[bj][n] = *(const f32x4*)(gate + cb) * coef; bb[bj][n] = bias ? *(const f32x4*)(bias + cb) : (f32x4){0.f, 0.f, 0.f, 0.f};
      }
#pragma unroll
    for (int ai = 0; ai < 2; ++ai)
#pragma unroll
      for (int m = 0; m < 4; ++m) {
        const int rl = ai * 128 + wr * 64 + m * 16 + fr;
        const unsigned o = (unsigned)(brow + rl) * (unsigned)D + (unsigned)(pn * 256 + wc * 32 + 8 * fq);
        f32x4 v[2][2];
        float sm = 0.f;
#pragma unroll
        for (int bj = 0; bj < 2; ++bj)
#pragma unroll
          for (int n = 0; n < 2; ++n) {
            f32x4 xs;
            if (first) xs = *(const f32x4*)(src + o + bj * 128 + 4 * n);
            else { const h16x4 xh = *(const h16x4*)(X + o + bj * 128 + 4 * n); xs = (f32x4){(float)xh[0], (float)xh[1], (float)xh[2], (float)xh[3]}; }
            v[bj][n] = xs * ALPHA + gt[bj][n] * (acc[ai][bj][m][n] + bb[bj][n]);
            sm += (v[bj][n][0] + v[bj][n][1]) + (v[bj][n][2] + v[bj][n][3]);
          }
        sm += shx(sm, 16, tid & 63); sm += shx(sm, 32, tid & 63);
        const float mw = sm * (1.f / 64.f); float q = 0.f;
#pragma unroll
        for (int bj = 0; bj < 2; ++bj)
#pragma unroll
          for (int n = 0; n < 2; ++n) { const f32x4 d = v[bj][n] - mw; q += (d[0] * d[0] + d[1] * d[1]) + (d[2] * d[2] + d[3] * d[3]); }
        q += shx(q, 16, tid & 63); q += shx(q, 32, tid & 63);
        if (fq == 0) P[rl * 4 + wc] = (f32x2){mw, q};
      }
    XBAR();
    if (tid < 256) {
      const f32x2 a = P[tid * 4 + 0], b = P[tid * 4 + 1], c2 = P[tid * 4 + 2], d = P[tid * 4 + 3];
      const float mt = (a.x + b.x + c2.x + d.x) * 0.25f;
      const float da = a.x - mt, db = b.x - mt, dc = c2.x - mt, dd = d.x - mt;
      const float M2 = (a.y + b.y + c2.y + d.y) + 64.f * (da * da + db * db + dc * dc + dd * dd);
      const unsigned long long pk = ((unsigned long long)__float_as_uint(M2) << 32) | (unsigned long long)__float_as_uint(mt);
      __hip_atomic_store(xb + ((size_t)pm * 256 + tid) * 4 + pn, pk, __ATOMIC_RELAXED, __HIP_MEMORY_SCOPE_AGENT);
    }
    asm volatile("s_waitcnt vmcnt(0)" ::: "memory");
    XBAR();
    if (tid == 0) {
      __hip_atomic_fetch_add(cnt + pm * 16, 1u, __ATOMIC_RELAXED, __HIP_MEMORY_SCOPE_AGENT);
      while (__hip_atomic_load(cnt + pm * 16, __ATOMIC_RELAXED, __HIP_MEMORY_SCOPE_AGENT) < 4u) __builtin_amdgcn_s_sleep(1);
    }
    XBAR();
    if (tid < 256) {
      float mi[4], qi[4];
#pragma unroll
      for (int j = 0; j < 4; ++j) {
        const unsigned long long pk = __hip_atomic_load(xb + ((size_t)pm * 256 + tid) * 4 + j, __ATOMIC_RELAXED, __HIP_MEMORY_SCOPE_AGENT);
        mi[j] = __uint_as_float((unsigned)(pk & 0xffffffffull)); qi[j] = __uint_as_float((unsigned)(pk >> 32));
      }
      const float mean = (mi[0] + mi[1] + mi[2] + mi[3]) * 0.25f;
      float M2 = qi[0] + qi[1] + qi[2] + qi[3];
#pragma unroll
      for (int j = 0; j < 4; ++j) { const float dm = mi[j] - mean; M2 += 256.f * dm * dm; }
      St[tid] = (f32x2){mean, rsqrtf(M2 * (1.f / D) + LN_EPS)};
    }
    XBAR();
    const float* mdn = MODn ? MODn + (size_t)crow * 4 * NMODC : nullptr;
    { int t2 = tid; asm volatile("" : "+v"(t2)); fr = t2 & 15; fq = (t2 >> 4) & 3; }
#pragma unroll
    for (int bj = 0; bj < 2; ++bj) {
      const int cb = pn * 256 + bj * 128 + wc * 32 + 8 * fq;
      f32x4 g4[2], b4[2], sh[2], sc[2], gt5[2], bb5[2];
#pragma unroll
      for (int n = 0; n < 2; ++n) {
        gt5[n] = *(const f32x4*)(gate + cb + 4 * n) * coef; bb5[n] = bias ? *(const f32x4*)(bias + cb + 4 * n) : (f32x4){0.f, 0.f, 0.f, 0.f};
        g4[n] = *(const f32x4*)(lng + cb + 4 * n); b4[n] = *(const f32x4*)(lnb + cb + 4 * n);
        if (mdn) { sh[n] = *(const f32x4*)(mdn + cb + 4 * n); sc[n] = *(const f32x4*)(mdn + D + cb + 4 * n) + 1.f; }
      }
#pragma unroll
      for (int ai = 0; ai < 2; ++ai)
#pragma unroll
        for (int m = 0; m < 4; ++m) {
          const int rl = ai * 128 + wr * 64 + m * 16 + fr;
          const f32x2 st = St[rl];
          const unsigned o = (unsigned)(brow + rl) * (unsigned)D + (unsigned)cb;
          h16x8 hv, xv;
          f32x4 xs[2];
          if (first) { xs[0] = *(const f32x4*)(src + o); xs[1] = *(const f32x4*)(src + o + 4); }
          else { const h16x8 xh = *(const h16x8*)(X + o);
#pragma unroll
            for (int e = 0; e < 4; ++e) { xs[0][e] = (float)xh[e]; xs[1][e] = (float)xh[4 + e]; } }
#pragma unroll
          for (int n = 0; n < 2; ++n) {
            const f32x4 vv = xs[n] * ALPHA + gt5[n] * (acc[ai][bj][m][n] + bb5[n]);
            const f32x4 y = (vv - st.x) * st.y * g4[n] + b4[n];
            if (last) *(f32x4*)(dstX + o + 4 * n) = y;
            else {
              const f32x4 hm = y * sc[n] + sh[n];
#pragma unroll
              for (int e = 0; e < 4; ++e) { hv[4 * n + e] = (h16)hm[e]; xv[4 * n + e] = (h16)y[e]; }
            }
          }
          if (!last) { *(h16x8*)(X + o) = xv; *(h16x8*)(H + o) = hv; }
        }
    }
  }
  __device__ __forceinline__ void operator()(const f32x4 (&acc)[2][2][4][2], int, int, int, int, int, int) const {}
};
struct EpiBranch {   static constexpr bool FUSED = false, BRANCH = true;
  const h16* Gt; h16* MG;
  __device__ __forceinline__ void operator()(const f32x4 (&acc)[2][2][4][2], int, int, int, int, int, int) const {}
  __device__ __forceinline__ void branch(f32x4 (&acc)[2][2][4][2], int pm, int pn, int wr, int wc, int fr, int fq, int pass) const {
    { int t_ = fr | (fq << 4); asm volatile("" : "+v"(t_)); fr = t_ & 15; fq = t_ >> 4; }
    constexpr float TINY = 6.103515625e-05f;
#pragma unroll
    for (int bj = 0; bj < 2; ++bj) {
      const int cb = pn * 256 + bj * 128 + wc * 32 + 8 * fq;
#pragma unroll
      for (int ai = 0; ai < 2; ++ai)
#pragma unroll
        for (int m = 0; m < 4; ++m) {
          const int row = pm * 256 + ai * 128 + wr * 64 + m * 16 + fr;
          const h16* gp_ = Gt + (size_t)row * 3072 + cb;
          const h16x8 gnum = *(const h16x8*)(gp_ + pass * D);
          h16x8 gden;
          if (pass < 2) gden = *(const h16x8*)(gp_ + (pass + 1) * D);
          h16x8 o;
#pragma unroll
          for (int n = 0; n < 2; ++n)
#pragma unroll
            for (int e = 0; e < 4; ++e) {
              float num = (float)gnum[4 * n + e];
              if (pass > 0) num = fmaxf(num, TINY);
              float f = num;
              if (pass < 2) f = num * __builtin_amdgcn_rcpf(fmaxf((float)gden[4 * n + e], TINY));
              const float v = acc[ai][bj][m][n][e] * f;
              acc[ai][bj][m][n][e] = v;
              o[4 * n + e] = (h16)v;
            }
          if (pass == 2) *(h16x8*)(MG + (size_t)row * D + cb) = o;
        }
    }
  }
};
struct EpiIn {       static constexpr bool FUSED = false, BRANCH = false;
  unsigned char* ws; float* out; const float* bin; int l;
  __device__ __forceinline__ void operator()(const f32x4 (&acc)[2][2][4][2], int pm, int pn, int wr, int wc, int fr, int fq) const {
    { int t_ = fr | (fq << 4); asm volatile("" : "+v"(t_)); fr = t_ & 15; fq = t_ >> 4; }
    const int brow = pm * 256;
    const bool sample = brow >= MP;
    const int sb = sample ? ((brow - MP) >> 11) : (brow >> 8);
    const int pos0 = sample ? ((brow - MP) & 2047) : 0;
    if (pn < 4) {
      const bool isq = pn < 2;
      const int sec = isq ? 0 : 512;
      h16* Qb = (h16*)(ws + OFF_Q);
      h16* Kdst = sample ? ((h16*)(ws + OFF_KS) + ((size_t)sb * 2560 + 512 + pos0) * 512) : ((h16*)(ws + OFF_KP) + (size_t)sb * 256 * 512);
      const float qs = isq ? (0.125f * 1.4426950408889634f) : 1.f;
      float invf[4];
#pragma unroll
      for (int e = 0; e < 4; ++e) invf[e] = __builtin_amdgcn_exp2f(-(float)(4 * fq + e) * (13.287712379549449f / 16.f));
#pragma unroll
      for (int bj = 0; bj < 2; ++bj) {
        const int c0 = pn * 256 - sec + bj * 128 + wc * 32 + 4 * fq;
        const f32x4 b1 = *(const f32x4*)(bin + sec + c0), b2 = *(const f32x4*)(bin + sec + c0 + 16);
#pragma unroll
        for (int ai = 0; ai < 2; ++ai)
#pragma unroll
          for (int m = 0; m < 4; ++m) {
            const int rl = ai * 128 + wr * 64 + m * 16 + fr;
            f32x4 x1 = acc[ai][bj][m][0] + b1, x2 = acc[ai][bj][m][1] + b2;
            if (!isq && !sample) {
              float* ok = out + OUT_K + ((size_t)(sb * 4 + l) * 256 + rl) * 512 + c0;
              *(f32x4*)ok = x1; *(f32x4*)(ok + 16) = x2;
            }
            if (sample) {
              const int pos = pos0 + rl;
              const float pp = (float)((wc & 1) ? (pos & 63) : (pos >> 6));
#pragma unroll
              for (int e = 0; e < 4; ++e) {
                const float ang = pp * invf[e];
                const float cs = __cosf(ang), sn = __sinf(ang);
                const float y1 = x1[e] * cs - x2[e] * sn, y2 = x2[e] * cs + x1[e] * sn;
                x1[e] = y1; x2[e] = y2;
              }
            }
            h16x4 o1, o2;
#pragma unroll
            for (int e = 0; e < 4; ++e) { o1[e] = (h16)(x1[e] * qs); o2[e] = (h16)(x2[e] * qs); }
            h16* d = isq ? (Qb + (size_t)(brow + rl) * 512 + c0) : (Kdst + (size_t)rl * 512 + c0);
            *(h16x4*)d = o1; *(h16x4*)(d + 16) = o2;
          }
      }
    } else if (pn < 6) {
      const int S = sample ? 2560 : 256;
      h16* Vt = sample ? ((h16*)(ws + OFF_VTS) + (size_t)sb * 4 * 128 * 2560 + 512 + pos0) : ((h16*)(ws + OFF_VTP) + (size_t)sb * 4 * 128 * 256);
#pragma unroll
      for (int bj = 0; bj < 2; ++bj)
#pragma unroll
        for (int n = 0; n < 2; ++n) {
          const int vc = pn * 256 - 1024 + bj * 128 + wc * 32 + 8 * fq + 4 * n;
          const f32x4 bb = *(const f32x4*)(bin + 1024 + vc);
#pragma unroll
          for (int ai = 0; ai < 2; ++ai)
#pragma unroll
            for (int m = 0; m < 4; ++m) {
              const int rl = ai * 128 + wr * 64 + m * 16 + fr;
              const f32x4 v = acc[ai][bj][m][n] + bb;
              if (!sample) *(f32x4*)(out + OUT_V + ((size_t)(sb * 4 + l) * 256 + rl) * 512 + vc) = v;
#pragma unroll
              for (int e = 0; e < 4; ++e) Vt[(size_t)(vc + e) * S + rl] = (h16)v[e];
            }
        }
    } else if (pn < 8) {
      h16* U = (h16*)(ws + OFF_U);
      const int ac = (pn - 6) * 128 + wc * 32 + 8 * fq;
      f32x4 ba[2], bg[2];
#pragma unroll
      for (int n = 0; n < 2; ++n) { ba[n] = *(const f32x4*)(bin + 1536 + ac + 4 * n); bg[n] = *(const f32x4*)(bin + 1536 + 256 + ac + 4 * n); }
#pragma unroll
      for (int ai = 0; ai < 2; ++ai)
#pragma unroll
        for (int m = 0; m < 4; ++m) {
          const int row = brow + ai * 128 + wr * 64 + m * 16 + fr;
          h16x8 o;
#pragma unroll
          for (int n = 0; n < 2; ++n)
#pragma unroll
            for (int e = 0; e < 4; ++e) { const float a = acc[ai][0][m][n][e] + ba[n][e], g = acc[ai][1][m][n][e] + bg[n][e]; o[4 * n + e] = (h16)(a * sigmoidf_(g)); }
          *(h16x8*)(U + (size_t)row * 256 + ac) = o;
        }
    } else {
      const bool isg = pn >= 9;
      h16* dst = isg ? (h16*)(ws + OFF_ACT) : (h16*)(ws + OFF_PU);
      const int ld = isg ? 3072 : 256;
      const int secb = isg ? 2304 : 2048;
#pragma unroll
      for (int bj = 0; bj < 2; ++bj) {
        const int cc = pn * 256 - secb + bj * 128 + wc * 32 + 8 * fq;
        f32x4 bb[2];
#pragma unroll
        for (int n = 0; n < 2; ++n) bb[n] = *(const f32x4*)(bin + secb + cc + 4 * n);
#pragma unroll
        for (int ai = 0; ai < 2; ++ai)
#pragma unroll
          for (int m = 0; m < 4; ++m) {
            const int row = brow + ai * 128 + wr * 64 + m * 16 + fr;
            h16x8 o;
#pragma unroll
            for (int n = 0; n < 2; ++n)
#pragma unroll
              for (int e = 0; e < 4; ++e) { const float v = acc[ai][bj][m][n][e] + bb[n][e]; o[4 * n + e] = (h16)(isg ? sigmoidf_(v) : v); }
            *(h16x8*)(dst + (size_t)row * ld + cc) = o;
          }
      }
    }
  }
};

enum { G_UP = 0, G_DOWN = 1, G_INPROJ = 2, G_BRANCH = 3, G_OUT = 4 };

__device__ __forceinline__ void ctx_convert(const Ctx& c, int l, int w0, int nwk) {
  unsigned char* ws = c.ws;
  {
    const int gt = w0 * 512 + c.tid, ng = nwk * 512;
    const float* ck = c.in[I_CK]; const float* cv = c.in[I_CV];
    h16* KS = (h16*)(ws + OFF_KS); h16* VTS = (h16*)(ws + OFF_VTS);
    for (int i = gt; i < 8 * 512 * 128; i += ng) {
      const int b = i >> 16, rem = i & 65535, key = rem >> 7, c4 = (rem & 127) * 4;
      const float4 kv = *(const float4*)(ck + (((size_t)(b * 4 + l) * 512 + key) * 512 + c4));
      h16x4 hk; hk[0] = (h16)kv.x; hk[1] = (h16)kv.y; hk[2] = (h16)kv.z; hk[3] = (h16)kv.w;
      *(h16x4*)(KS + ((size_t)b * 2560 + key) * 512 + c4) = hk;
    }
    for (int i = gt; i < 8 * 128 * 512; i += ng) {
      const int b = i >> 16, rem = i & 65535, k4 = rem >> 9, vc = rem & 511;
      h16x4 hv;
#pragma unroll
      for (int j = 0; j < 4; ++j) hv[j] = (h16)cv[((size_t)(b * 4 + l) * 512 + k4 * 4 + j) * 512 + vc];
      *(h16x4*)(VTS + ((size_t)b * 512 + vc) * 2560 + k4 * 4) = hv;
    }
  }
}

constexpr int AT_KP = 272, AT_VP = 144, AT_KB = 64 * AT_KP, AT_VB = 128 * AT_VP, AT_BUF = AT_KB + AT_VB;

__device__ __forceinline__ void attn_qk(const unsigned char* Kl, const h16x8 (&q)[4], f32x16& s0, f32x16& s1, int kap, int mp, int hh) {
#pragma unroll
  for (int i = 0; i < 16; ++i) { s0[i] = 0.f; s1[i] = 0.f; }
  const unsigned char* kp = Kl + kap * AT_KP + (mp * 64 + hh * 8) * 2;
  h16x8 ka[2][4];
#pragma unroll
  for (int ks = 0; ks < 4; ++ks) { ka[0][ks] = *(const h16x8*)(kp + ks * 32); ka[1][ks] = *(const h16x8*)(kp + 32 * AT_KP + ks * 32); }
#pragma unroll
  for (int ks = 0; ks < 4; ++ks) {
    s0 = __builtin_amdgcn_mfma_f32_32x32x16_f16(ka[0][ks], q[ks], s0, 0, 0, 0);
    s1 = __builtin_amdgcn_mfma_f32_32x32x16_f16(ka[1][ks], q[ks], s1, 0, 0, 0);
  }
}
__device__ __forceinline__ void attn_softmax(f32x16& s0, f32x16& s1, h16x8 (&pb)[4], f32x16 (&O)[4], float& mrun, float& lsum, int lane) {
  float mx = s0[0];
#pragma unroll
  for (int i = 1; i < 16; ++i) mx = fmaxf(mx, s0[i]);
#pragma unroll
  for (int i = 0; i < 16; ++i) mx = fmaxf(mx, s1[i]);
  mx = fmaxf(mx, shx(mx, 32, lane));
  const float mnew = fmaxf(mrun, mx);
  if (__any(mnew > mrun)) {
    const float al = __builtin_amdgcn_exp2f(mrun - mnew);
    lsum *= al;
#pragma unroll
    for (int f = 0; f < 4; ++f)
#pragma unroll
      for (int i = 0; i < 16; ++i) O[f][i] *= al;
    mrun = mnew;
  }
  typedef float f32x2 __attribute__((ext_vector_type(2)));
  const f32x2 mm = {mrun, mrun};
  f32x2 ps2 = {0.f, 0.f};
#pragma unroll
  for (int i = 0; i < 8; ++i) {
    f32x2 d = (f32x2){s0[2 * i], s0[2 * i + 1]} - mm;
    d.x = __builtin_amdgcn_exp2f(d.x); d.y = __builtin_amdgcn_exp2f(d.y);
    ps2 += d; s0[2 * i] = d.x; s0[2 * i + 1] = d.y;
  }
#pragma unroll
  for (int i = 0; i < 8; ++i) {
    f32x2 d = (f32x2){s1[2 * i], s1[2 * i + 1]} - mm;
    d.x = __builtin_amdgcn_exp2f(d.x); d.y = __builtin_amdgcn_exp2f(d.y);
    ps2 += d; s1[2 * i] = d.x; s1[2 * i + 1] = d.y;
  }
  lsum += ps2.x + ps2.y;
#pragma unroll
  for (int j = 0; j < 8; ++j) { pb[0][j] = (h16)s0[j]; pb[1][j] = (h16)s0[8 + j]; pb[2][j] = (h16)s1[j]; pb[3][j] = (h16)s1[8 + j]; }
}
__device__ __forceinline__ void attn_pv(const unsigned char* Vl, const h16x8 (&pb)[4], f32x16 (&O)[4], int r, int hh) {
  const unsigned char* vp = Vl + r * AT_VP + hh * 16;
  h16x8 va[4], vb[4];
#pragma unroll
  for (int f = 0; f < 4; ++f) va[f] = *(const h16x8*)(vp + f * 32 * AT_VP);
#pragma unroll
  for (int f = 0; f < 4; ++f) vb[f] = *(const h16x8*)(vp + f * 32 * AT_VP + 32);
#pragma unroll
  for (int f = 0; f < 4; ++f) O[f] = __builtin_amdgcn_mfma_f32_32x32x16_f16(va[f], pb[0], O[f], 0, 0, 0);
#pragma unroll
  for (int f = 0; f < 4; ++f) va[f] = *(const h16x8*)(vp + f * 32 * AT_VP + 64);
#pragma unroll
  for (int f = 0; f < 4; ++f) O[f] = __builtin_amdgcn_mfma_f32_32x32x16_f16(vb[f], pb[1], O[f], 0, 0, 0);
#pragma unroll
  for (int f = 0; f < 4; ++f) vb[f] = *(const h16x8*)(vp + f * 32 * AT_VP + 96);
#pragma unroll
  for (int f = 0; f < 4; ++f) O[f] = __builtin_amdgcn_mfma_f32_32x32x16_f16(va[f], pb[2], O[f], 0, 0, 0);
#pragma unroll
  for (int f = 0; f < 4; ++f) O[f] = __builtin_amdgcn_mfma_f32_32x32x16_f16(vb[f], pb[3], O[f], 0, 0, 0);
}

__device__ __forceinline__ void attn_item(const Ctx& c, int l, int item, float lam, float post) {
  unsigned char* ws = c.ws; unsigned char* lds = c.lds;
  const bool sample = item < 512;
  int b, h, qb, S, tok0; const h16* Kb; const h16* Vt;
  if (sample) { b = item >> 6; h = (item >> 4) & 3; qb = item & 15; S = 2560; tok0 = MP + b * 2048 + qb * 128;
                Kb = (const h16*)(ws + OFF_KS) + (size_t)b * 2560 * 512 + h * 128; Vt = (const h16*)(ws + OFF_VTS) + (size_t)(b * 4 + h) * 128 * 2560; }
  else { const int it = item - 512; b = it >> 3; h = (it >> 1) & 3; qb = it & 1; S = 256; tok0 = b * 256 + qb * 128;
         Kb = (const h16*)(ws + OFF_KP) + (size_t)b * 256 * 512 + h * 128; Vt = (const h16*)(ws + OFF_VTP) + (size_t)(b * 4 + h) * 128 * 256; }
  const int w = CWAVE, mp = w >> 2, qg = w & 3, r = CLANE & 31, hh = CLANE >> 5;
  const int kap = (r & ~12) | ((r & 4) << 1) | ((r & 8) >> 1);
  const h16* Qp = (const h16*)(ws + OFF_Q) + (size_t)(tok0 + qg * 32 + r) * 512 + h * 128 + mp * 64 + hh * 8;
  h16x8 q[4];
#pragma unroll
  for (int ks = 0; ks < 4; ++ks) q[ks] = *(const h16x8*)(Qp + ks * 16);
  f32x16 O[4];
#pragma unroll
  for (int f = 0; f < 4; ++f)
#pragma unroll
    for (int i = 0; i < 16; ++i) O[f][i] = 0.f;
  float mrun = -1e30f, lsum = 0.f;
  const int nT = S >> 6;
  const int t0r = sample ? (qb * 5) >> 1 : qb * 2;
#define TILE(t) (((t) + t0r) >= nT ? ((t) + t0r - nT) : ((t) + t0r))
  const int kr0 = c.tid >> 4, kc = c.tid & 15;
  const int ve0 = c.tid >> 3, vch = c.tid & 7;
  const h16* kg = Kb + (size_t)kr0 * 512 + kc * 8;
  const h16* vg = Vt + (size_t)ve0 * S + vch * 8;
  unsigned char* kl0 = lds + kr0 * AT_KP + kc * 16;
  unsigned char* vl0 = lds + AT_KB + ve0 * AT_VP + vch * 16;
  h16x8 kA[2], vA[2];
#define AT_LOAD(t) do { _Pragma("unroll") for (int i_ = 0; i_ < 2; ++i_) { \
    kA[i_] = *(const h16x8*)(kg + (size_t)((t) * 64 + i_ * 32) * 512); vA[i_] = *(const h16x8*)(vg + (size_t)(i_ * 64) * S + (t) * 64); } } while (0)
#define AT_WRITE(boff) do { _Pragma("unroll") for (int i_ = 0; i_ < 2; ++i_) { \
    *(h16x8*)(kl0 + (boff) + i_ * 32 * AT_KP) = kA[i_]; *(h16x8*)(vl0 + (boff) + i_ * 64 * AT_VP) = vA[i_]; } } while (0)
  {
    h16x8 kB[2], vB[2], kC[2], vC[2];
#pragma unroll
    for (int i_ = 0; i_ < 2; ++i_) {
      kA[i_] = *(const h16x8*)(kg + (size_t)(TILE(0) * 64 + i_ * 32) * 512);  vA[i_] = *(const h16x8*)(vg + (size_t)(i_ * 64) * S + TILE(0) * 64);
      kB[i_] = *(const h16x8*)(kg + (size_t)(TILE(1) * 64 + i_ * 32) * 512);  vB[i_] = *(const h16x8*)(vg + (size_t)(i_ * 64) * S + TILE(1) * 64);
      kC[i_] = *(const h16x8*)(kg + (size_t)(TILE(2) * 64 + i_ * 32) * 512);  vC[i_] = *(const h16x8*)(vg + (size_t)(i_ * 64) * S + TILE(2) * 64);
    }
    AT_WRITE(0);
#pragma unroll
    for (int i_ = 0; i_ < 2; ++i_) { *(h16x8*)(kl0 + AT_BUF + i_ * 32 * AT_KP) = kB[i_]; *(h16x8*)(vl0 + AT_BUF + i_ * 64 * AT_VP) = vB[i_]; kA[i_] = kC[i_]; vA[i_] = vC[i_]; }
  }
  __syncthreads();
  f32x16 s0, s1, n0, n1;
  attn_qk(lds, q, s0, s1, kap, mp, hh);
  int bc = 0, bn = AT_BUF, bw = 2 * AT_BUF;
  for (int kt = 0; kt < nT; ++kt) {
    if (kt + 2 < nT) AT_WRITE(bw);
    if (kt + 3 < nT) AT_LOAD(TILE(kt + 3));
    if (kt + 1 < nT) attn_qk(lds + bn, q, n0, n1, kap, mp, hh);
    __builtin_amdgcn_sched_barrier(0);
    h16x8 pb[4];
    attn_softmax(s0, s1, pb, O, mrun, lsum, CLANE);
    attn_pv(lds + bc + AT_KB, pb, O, r, hh);
    __syncthreads();
    s0 = n0; s1 = n1;
    const int t_ = bc; bc = bn; bn = bw; bw = t_;
  }
#undef AT_LOAD
#undef AT_WRITE
#undef TILE
  const float inv = 1.f / (lsum + shx(lsum, 32, CLANE));
  f32x4* ex = (f32x4*)lds;
  const float* sg = c.in[I_SUBG] + (size_t)(l * 4 + h) * 128;
  float4 gg[4][4];
  if (mp == 1) {
#pragma unroll
    for (int f = 0; f < 4; ++f)
#pragma unroll
      for (int g = 0; g < 4; ++g)
        ex[((qg * 4 + f) * 4 + g) * 64 + CLANE] = (f32x4){O[f][4 * g + 0], O[f][4 * g + 1], O[f][4 * g + 2], O[f][4 * g + 3]} * inv;
  } else {
#pragma unroll
    for (int f = 0; f < 4; ++f)
#pragma unroll
      for (int g = 0; g < 4; ++g) gg[f][g] = *(const float4*)(sg + f * 32 + 8 * g + 4 * hh);
  }
  __syncthreads();
  if (mp == 0) {
    float ss = 0.f;
#pragma unroll
    for (int f = 0; f < 4; ++f)
#pragma unroll
      for (int g = 0; g < 4; ++g) {
        const f32x4 e4 = ex[((qg * 4 + f) * 4 + g) * 64 + CLANE];
#pragma unroll
        for (int j = 0; j < 4; ++j) { const float o = O[f][4 * g + j] * inv - lam * e4[j]; O[f][4 * g + j] = o; ss += o * o; }
      }
    ss += shx(ss, 32, CLANE);
    const float rs = rsqrtf(ss * (1.f / 128.f) + LN_EPS) * post;
    h16* Od = (h16*)(ws + OFF_OATT) + (size_t)(h >> 1) * MT * 256 + (size_t)(tok0 + qg * 32 + r) * 256 + (h & 1) * 128;
#pragma unroll
    for (int f = 0; f < 4; ++f)
#pragma unroll
      for (int g = 0; g < 4; ++g) {
        const int e0 = f * 32 + 8 * g + 4 * hh;
        h16x4 pk;
        pk[0] = (h16)(O[f][4 * g + 0] * rs * gg[f][g].x); pk[1] = (h16)(O[f][4 * g + 1] * rs * gg[f][g].y);
        pk[2] = (h16)(O[f][4 * g + 2] * rs * gg[f][g].z); pk[3] = (h16)(O[f][4 * g + 3] * rs * gg[f][g].w);
        *(h16x4*)(Od + e0) = pk;
      }
  }
  __syncthreads();
}

__device__ __forceinline__ void mix_phase(const Ctx& c, int l) {
  unsigned char* ws = c.ws;
  {
    const float* lq = c.in[I_LAM] + (size_t)l * 256;
    const float d1 = wave_sum(lq[CLANE] * lq[64 + CLANE], CLANE);
    const float d2 = wave_sum(lq[128 + CLANE] * lq[192 + CLANE], CLANE);
    const float lam_init = 0.8f - 0.6f * expf(-0.3f * (float)l);
    const float lam = expf(d1) - expf(d2) + lam_init;
    const int G = c.G, bx = c.bx;
    const int lid = (G % 8 == 0) ? (bx % 8) * (G / 8) + bx / 8 : bx;
    for (int item = lid; item < 768; item += G) attn_item(c, l, item, lam, 1.f - lam_init);
  }
  const int gw = c.bx * 8 + CWAVE, nw = c.G * 8;
  {
    const h16* U = (const h16*)(ws + OFF_U);
    h16* UC = (h16*)(ws + OFF_UC);
    const float* cw = c.in[I_CDW] + (size_t)l * 31 * 256 + CLANE * 4;
    float4 wv[31];
#pragma unroll
    for (int k = 0; k < 31; ++k) wv[k] = *(const float4*)(cw + k * 256);
    const float4 cb = *(const float4*)(c.in[I_CDB] + l * 256 + CLANE * 4);
    const float4 lg = *(const float4*)(c.in[I_CLG] + l * 256 + CLANE * 4);
    const float4 lb = *(const float4*)(c.in[I_CLB] + l * 256 + CLANE * 4);
    for (int tb = gw * 4; tb < MT; tb += nw * 4) {
      const int sbeg = tb < MP ? (tb & ~255) : MP + ((tb - MP) & ~2047);
      const int send = tb < MP ? sbeg + 256 : sbeg + 2048;
      h16x4 row[34];
#pragma unroll
      for (int r = 0; r < 34; ++r) {
        const int g = tb - 15 + r;
        const bool ok = (g >= sbeg && g < send);
        row[r] = *(const h16x4*)(U + (size_t)(ok ? g : tb) * 256 + CLANE * 4);
        if (!ok) { row[r][0] = (h16)0.f; row[r][1] = (h16)0.f; row[r][2] = (h16)0.f; row[r][3] = (h16)0.f; }
      }
      float4 a[4];
#pragma unroll
      for (int i = 0; i < 4; ++i) a[i] = cb;
#pragma unroll
      for (int k = 0; k < 31; ++k)
#pragma unroll
        for (int i = 0; i < 4; ++i) {
          a[i].x += wv[k].x * (float)row[i + k][0]; a[i].y += wv[k].y * (float)row[i + k][1]; a[i].z += wv[k].z * (float)row[i + k][2]; a[i].w += wv[k].w * (float)row[i + k][3];
        }
      float sm[4], sq[4];
#pragma unroll
      for (int i = 0; i < 4; ++i) sm[i] = a[i].x + a[i].y + a[i].z + a[i].w;
#pragma unroll
      for (int o = 32; o >= 1; o >>= 1)
#pragma unroll
        for (int i = 0; i < 4; ++i) sm[i] += shx(sm[i], o, CLANE);
#pragma unroll
      for (int i = 0; i < 4; ++i) {
        const float mean = sm[i] * (1.f / 256.f);
        a[i].x -= mean; a[i].y -= mean; a[i].z -= mean; a[i].w -= mean;
        sq[i] = a[i].x * a[i].x + a[i].y * a[i].y + a[i].z * a[i].z + a[i].w * a[i].w;
      }
#pragma unroll
      for (int o = 32; o >= 1; o >>= 1)
#pragma unroll
        for (int i = 0; i < 4; ++i) sq[i] += shx(sq[i], o, CLANE);
#pragma unroll
      for (int i = 0; i < 4; ++i) {
        const float rstd = rsqrtf(sq[i] * (1.f / 256.f) + LN_EPS);
        const float y0 = a[i].x * rstd * lg.x + lb.x, y1 = a[i].y * rstd * lg.y + lb.y, y2 = a[i].z * rstd * lg.z + lb.z, y3 = a[i].w * rstd * lg.w + lb.w;
        h16x4 o; o[0] = (h16)(y0 * sigmoidf_(y0)); o[1] = (h16)(y1 * sigmoidf_(y1)); o[2] = (h16)(y2 * sigmoidf_(y2)); o[3] = (h16)(y3 * sigmoidf_(y3));
        *(h16x4*)(UC + (size_t)(tb + i) * 256 + CLANE * 4) = o;
      }
    }
  }
  {
    const h16* PU = (const h16*)(ws + OFF_PU);
    h16* PL = (h16*)(ws + OFF_PL);
    const int hw = 1 << (CLANE >> 4);
    float wm[16];
#pragma unroll
    for (int k = -8; k < 8; ++k) wm[k + 8] = (k >= -hw && k < hw) ? 1.f : 0.f;
    for (int tb = gw * 4; tb < MT; tb += nw * 4) {
      const int sbeg = tb < MP ? (tb & ~255) : MP + ((tb - MP) & ~2047);
      const int L = tb < MP ? 256 : 2048, send = sbeg + L;
      h16x4 row[19];
#pragma unroll
      for (int r = 0; r < 19; ++r) {
        const int g = tb - 8 + r;
        const bool ok = (g >= sbeg && g < send);
        row[r] = *(const h16x4*)(PU + (size_t)(ok ? g : tb) * 256 + CLANE * 4);
        if (!ok) { row[r][0] = (h16)0.f; row[r][1] = (h16)0.f; row[r][2] = (h16)0.f; row[r][3] = (h16)0.f; }
      }
#pragma unroll
      for (int i = 0; i < 4; ++i) {
        float s0 = 0.f, s1 = 0.f, s2 = 0.f, s3 = 0.f;
#pragma unroll
        for (int k = 0; k < 16; ++k) { s0 += wm[k] * (float)row[i + k][0]; s1 += wm[k] * (float)row[i + k][1]; s2 += wm[k] * (float)row[i + k][2]; s3 += wm[k] * (float)row[i + k][3]; }
        const int pos = tb + i - sbeg;
        const int lo = max(pos - hw, 0), hi = min(pos + hw, L);
        const float rc = 1.f / (float)(hi - lo);
        const h16x4 u = row[i + 8];
        h16x4 o; o[0] = (h16)(s0 * rc - (float)u[0]); o[1] = (h16)(s1 * rc - (float)u[1]); o[2] = (h16)(s2 * rc - (float)u[2]); o[3] = (h16)(s3 * rc - (float)u[3]);
        *(h16x4*)(PL + (size_t)(tb + i) * 256 + CLANE * 4) = o;
      }
    }
  }
}

__device__ __forceinline__ void convert_tile(const Ctx& c, const float* __restrict__ src, int K, int N, h16* __restrict__ dst, int perm, int tile) {
  float* T = (float*)c.lds;
  const int nNt = N >> 8, kt = tile / nNt, nt = tile % nNt, k0 = kt * 64, n0 = nt * 256;
  {
    const int tx = c.tid & 63, ty = c.tid >> 6;
    float4 v[8];
#pragma unroll
    for (int i = 0; i < 8; ++i) v[i] = *(const float4*)(src + (size_t)(k0 + ty * 8 + i) * N + n0 + tx * 4);
#pragma unroll
    for (int i = 0; i < 8; ++i) { float* t = T + (ty * 8 + i) * 257 + tx * 4; t[0] = v[i].x; t[1] = v[i].y; t[2] = v[i].z; t[3] = v[i].w; }
  }
  __syncthreads();
  {
    const int n = c.tid >> 1, kh = c.tid & 1;
    int nn = n0 + n;
    if (perm == 1) {
      if (nn < DFF) nn = (nn >> 7) * 256 + (nn & 127); else { const int j = nn - DFF; nn = (j >> 7) * 256 + 128 + (j & 127); }
    } else if (perm == 2) {
      if (nn >= 1536 && nn < 2048) { const int q = nn - 1536; if (q < 256) nn = 1536 + (q >> 7) * 256 + (q & 127); else { const int j = q - 256; nn = 1536 + (j >> 7) * 256 + 128 + (j & 127); } }
    }
    if (!(perm == 2 && nn < 1024)) { const int ci = nn & 31; nn = (nn & ~31) + 16 * ((ci >> 2) & 1) + 4 * (ci >> 3) + (ci & 3); }
#pragma unroll
    for (int jv = 0; jv < 4; ++jv) {
      h16x8 o;
#pragma unroll
      for (int i = 0; i < 8; ++i) o[i] = (h16)T[(kh * 32 + jv * 8 + i) * 257 + n];
      *(h16x8*)(dst + (size_t)nn * K + k0 + kh * 32 + jv * 8) = o;
    }
  }
  __syncthreads();
}

constexpr int LAYER_TILES = 2 * 352 + 2 * 176 + 336 + 32 + 16 + 64;
__device__ __forceinline__ void convert_layer_tile(const Ctx& c, int l, int q) {
  unsigned char* ws = c.ws;
  if (q < 704)       { const int mi = l * 2 + q / 352; convert_tile(c, c.in[I_WFIN] + (size_t)mi * D * NUP, D, NUP, (h16*)(ws + OFF_WUP) + (size_t)mi * NUP * D, 1, q % 352); }
  else if (q < 1056) { q -= 704; const int mi = l * 2 + q / 176; convert_tile(c, c.in[I_WFOUT] + (size_t)mi * DFF * D, DFF, D, (h16*)(ws + OFF_WDN) + (size_t)mi * D * DFF, 0, q % 176); }
  else if (q < 1392) { q -= 1056; convert_tile(c, c.in[I_WIN] + (size_t)l * D * INC, D, INC, (h16*)(ws + OFF_WIN) + (size_t)l * INC * D, 2, q); }
  else if (q < 1424) { q -= 1392; const int mi = l * 2 + q / 16; convert_tile(c, c.in[I_WATT] + (size_t)mi * 256 * D, 256, D, (h16*)(ws + OFF_WATT) + (size_t)mi * D * 256, 0, q % 16); }
  else if (q < 1440) { q -= 1424; convert_tile(c, c.in[I_WCONV] + (size_t)l * 256 * D, 256, D, (h16*)(ws + OFF_WCONV) + (size_t)l * D * 256, 0, q); }
  else               { q -= 1440; convert_tile(c, c.in[I_WOUT] + (size_t)l * D * D, D, D, (h16*)(ws + OFF_WOUT) + (size_t)l * D * D, 0, q); }
}

__device__ __forceinline__ void phase0(const Ctx& c) {
  unsigned char* ws = c.ws;
  const int G = c.G;
  constexpr int N_MOD_IT = 144, N_POOL_IT = 256;
  constexpr int TOTAL = N_MOD_IT + N_POOL_IT + LAYER_TILES;
  const bool w256 = (G == 256);
  const int nsh = w256 ? 592 : G, sh0 = w256 ? (c.bx < 144 ? c.bx : 144 + 4 * (c.bx - 144)) : c.bx, nown = (w256 && c.bx >= 144) ? 4 : 1;
  const int n_other = TOTAL - N_MOD_IT;
  int vi = 0, j = sh0;
  bool mod_pending = c.bx < N_MOD_IT;
  int mod_it = c.bx;
  for (;;) {
    int it;
    if (mod_pending) { it = mod_it; mod_it += G; mod_pending = w256 ? false : (mod_it < N_MOD_IT); }
    else {
      while (vi < nown && j >= n_other) { ++vi; j = sh0 + vi; }
      if (vi >= nown) break;
      it = N_MOD_IT + j; j += nsh;
    }
    if (it < N_MOD_IT) {
      float* sc = (float*)c.lds;
      float* red = sc + 12 * 1024;
      for (int i = c.tid; i < 9 * 1024; i += 512) {
        const float x = (i < 1024) ? c.in[I_CCTX][i] : c.in[I_C][i - 1024];
        sc[(i & 1023) * 12 + (i >> 10)] = x * sigmoidf_(x);
      }
      __syncthreads();
      const int l = it / 36, cb = (it % 36) * 256;
      const float* wp = c.in[I_WMOD] + ((size_t)l * 1024 + CWAVE * 128) * NMODC + cb + CLANE * 4;
      float4 a[9];
#pragma unroll
      for (int r = 0; r < 9; ++r) a[r] = make_float4(0.f, 0.f, 0.f, 0.f);
      for (int k0 = 0; k0 < 128; k0 += 8) {
        float4 w4[8];
#pragma unroll
        for (int kk = 0; kk < 8; ++kk) w4[kk] = *(const float4*)(wp + (size_t)(k0 + kk) * NMODC);
#pragma unroll
        for (int kk = 0; kk < 8; ++kk) {
          const float* sp = sc + (CWAVE * 128 + k0 + kk) * 12;
          const float4 s0 = *(const float4*)sp, s1 = *(const float4*)(sp + 4); const float s8 = sp[8];
          const float sv[9] = {s0.x, s0.y, s0.z, s0.w, s1.x, s1.y, s1.z, s1.w, s8};
#pragma unroll
          for (int r = 0; r < 9; ++r) { a[r].x += sv[r] * w4[kk].x; a[r].y += sv[r] * w4[kk].y; a[r].z += sv[r] * w4[kk].z; a[r].w += sv[r] * w4[kk].w; }
        }
      }
#pragma unroll
      for (int r = 0; r < 9; ++r) *(float4*)(red + (CWAVE * 9 + r) * 256 + CLANE * 4) = a[r];
      __syncthreads();
      float* MOD = (float*)(ws + OFF_MOD);
      for (int i = c.tid; i < 9 * 256; i += 512) {
        const int r = i >> 8, cc = i & 255;
        float s = c.in[I_BMOD][(size_t)l * NMODC + cb + cc];
#pragma unroll
        for (int w = 0; w < 8; ++w) s += red[(w * 9 + r) * 256 + cc];
        MOD[(size_t)(r * 4 + l) * NMODC + cb + cc] = s;
      }
      __syncthreads();
    } else if (it < N_MOD_IT + N_POOL_IT) {
      const int q = it - N_MOD_IT, l = q >> 6, nch = (q >> 2) & 15, g = q & 3;
      float* wg = (float*)c.lds;
      float* wo = wg + 64 * 65;
      const float* wgp = c.in[I_WPG] + (size_t)(l * 4 + g) * 4096;
      const float* scp = c.in[I_PSC] + l * 256 + g * 64;
      const float* wop = c.in[I_WPO] + ((size_t)l * 256 + g * 64) * D + nch * 64;
      for (int i = c.tid; i < 4096; i += 512) {
        const int a = i >> 6, b2 = i & 63;
        wg[a * 65 + b2] = wgp[i] * scp[b2];
        wo[i] = wop[(size_t)a * D + b2];
      }
      __syncthreads();
      h16* dst = (h16*)(ws + OFF_WPOOL) + (size_t)l * D * 256;
      const int n = c.tid & 63;
#pragma unroll
      for (int i = 0; i < 8; ++i) {
        const int cil = (c.tid >> 6) * 8 + i;
        float s = 0.f;
        for (int co = 0; co < 64; ++co) s += wg[cil * 65 + co] * wo[co * 64 + n];
        const int nf = nch * 64 + n, ci = nf & 31, np = (nf & ~31) + 16 * ((ci >> 2) & 1) + 4 * (ci >> 3) + (ci & 3);
        dst[(size_t)np * 256 + g * 64 + cil] = (h16)s;
      }
      __syncthreads();
    } else {
      convert_layer_tile(c, 0, it - N_MOD_IT - N_POOL_IT);
    }
  }
}

__device__ __forceinline__ void phase0b(const Ctx& c) {
  const float* MOD = (const float*)(c.ws + OFF_MOD);
  h16* H = (h16*)(c.ws + OFF_H);
  const int gt = c.bx * 512 + c.tid, ng = c.G * 512;
  for (int i = gt; i < MT * (D / 4); i += ng) {
    const int row = i >> 8, c4 = (i & 255) * 4;
    const float* src = (row < MP) ? (c.in[I_XP] + (size_t)row * D) : (c.in[I_XS] + (size_t)(row - MP) * D);
    const float4 x = *(const float4*)(src + c4);
    const float* md = MOD + (size_t)(cond_row(row) * 4) * NMODC;
    const float4 sh = *(const float4*)(md + c4), sc = *(const float4*)(md + D + c4);
    h16x4 hv; hv[0] = (h16)(x.x * (1.f + sc.x) + sh.x); hv[1] = (h16)(x.y * (1.f + sc.y) + sh.y);
    hv[2] = (h16)(x.z * (1.f + sc.z) + sh.z); hv[3] = (h16)(x.w * (1.f + sc.w) + sh.w);
    *(h16x4*)(H + (size_t)row * D + c4) = hv;
  }
}

__device__ __forceinline__ void grid_bar(unsigned* w, unsigned gen, int tid, unsigned bx, unsigned G) {
  asm volatile("s_waitcnt vmcnt(0)" ::: "memory");
  __syncthreads();
  if (tid == 0) {
    __builtin_amdgcn_fence(__ATOMIC_RELEASE, "agent");
    asm volatile("s_waitcnt vmcnt(0)" ::: "memory");
    const unsigned g = bx & 7u, gsz = (G - g + 7u) >> 3, ngr = G < 8u ? G : 8u;
    const unsigned old = __hip_atomic_fetch_add(w + 64 * g, 1u, __ATOMIC_RELAXED, __HIP_MEMORY_SCOPE_AGENT);
    if (old == gen * gsz - 1u) {
      const unsigned t = __hip_atomic_fetch_add(w + 512, 1u, __ATOMIC_RELAXED, __HIP_MEMORY_SCOPE_AGENT);
      if (t == gen * ngr - 1u) __hip_atomic_store(w + 576, gen, __ATOMIC_RELAXED, __HIP_MEMORY_SCOPE_AGENT);
    }
    while (__hip_atomic_load(w + 576, __ATOMIC_RELAXED, __HIP_MEMORY_SCOPE_AGENT) < gen) __builtin_amdgcn_s_sleep(1);
    __builtin_amdgcn_fence(__ATOMIC_ACQUIRE, "agent");
    asm volatile("s_waitcnt vmcnt(0)" ::: "memory");
  }
  __syncthreads();
}

__global__ void __launch_bounds__(512, 2) fwd_kernel(Params p) {
  extern __shared__ __attribute__((aligned(16))) unsigned char lds[];
  cg::grid_group grid = cg::this_grid();
  for (int step = 0; step < 34; ++step) {
    int tid_ = threadIdx.x; asm volatile("" : "+v"(tid_));
    unsigned z_; asm volatile("s_mov_b32 %0, 0" : "=s"(z_));
    typedef const Params __attribute__((address_space(4))) CParams;
    CParams* kp = (CParams*)((const char __attribute__((address_space(4)))*)__builtin_amdgcn_kernarg_segment_ptr() + z_);
    unsigned char* ws_ = kp->ws;
    float* out_ = kp->out;
    InTab in_ = kp->in;
    int bx_ = blockIdx.x, G_ = gridDim.x; asm volatile("" : "+s"(bx_), "+s"(G_));
    Ctx c; c.bx = bx_; c.G = G_; c.in = in_; c.out = out_; c.ws = ws_; c.lds = lds; c.tid = tid_;
    if (step == 0) phase0(c);
    else if (step == 1) phase0b(c);
    else {
      const int l = (step - 2) >> 3, s = (step - 2) & 7;
      if (s == 3) mix_phase(c, l);
      else {
        LAS unsigned char* L3 = (LAS unsigned char*)lds;
        unsigned char* ws = c.ws;
        const float* MOD = (const float*)(ws + OFF_MOD);
        if (s == 0 || s == 6) {
          EpiUp E{(h16*)(ws + OFF_ACT)};
          gemm_stream(c.tid, c.bx, c.G, L3, (const h16*)(ws + OFF_H), (const h16*)(ws + OFF_WUP) + (size_t)(l * 2 + (s == 6)) * NUP * D, NUP, D, E);
          if (s == 0) { if (c.G == 256) { if (c.bx >= 64) ctx_convert(c, l, c.bx - 64, 192); } else ctx_convert(c, l, c.bx, c.G); }
        } else if (s == 1 || s == 5 || s == 7) {
          EpiResLn E{ws, c.in, c.out, l, s};
          if (s == 5) gemm_stream(c.tid, c.bx, c.G, L3, (const h16*)(ws + OFF_MG), (const h16*)(ws + OFF_WOUT) + (size_t)l * D * D, D, D, E);
          else {
            gemm_stream(c.tid, c.bx, c.G, L3, (const h16*)(ws + OFF_ACT), (const h16*)(ws + OFF_WDN) + (size_t)(l * 2 + (s == 7)) * D * DFF, D, DFF, E);
            if (l < 3) {
              const int half = (s == 7), w0 = (c.G == 256) ? c.bx - 128 : c.bx, nw = (c.G == 256) ? 128 : c.G;
              if (w0 >= 0) for (int q = half * (LAYER_TILES / 2) + w0; q < (half + 1) * (LAYER_TILES / 2); q += nw) convert_layer_tile(c, l + 1, q);
            }
          }
        } else if (s == 2) {
          EpiIn E{ws, c.out, c.in[I_BIN] + (size_t)l * INC, l};
          gemm_stream(c.tid, c.bx, c.G, L3, (const h16*)(ws + OFF_H), (const h16*)(ws + OFF_WIN) + (size_t)l * INC * D, INC, D, E);
        } else {
          EpiBranch E{(const h16*)(ws + OFF_ACT), (h16*)(ws + OFF_MG)};
          gemm_stream(c.tid, c.bx, c.G, L3, (const h16*)ws, (const h16*)ws, D, 256, E, l);
        }
      }
    }
    if (G_ == 0x7fffffff) grid.sync();
    if (step != 33) grid_bar((unsigned*)(ws_ + WS_END), (unsigned)(step + 1), tid_, (unsigned)bx_, (unsigned)G_);
  }
}

extern "C" void kernel_launch(void* const* d_in, const int* in_sizes, int n_in, void* d_out, int out_size,
                              void* d_ws, size_t ws_size, hipStream_t stream) {
  static int grid_blocks = 0;
  if (!grid_blocks) {
    int dev = 0, cus = 0, per_cu = 0;
    (void)hipGetDevice(&dev);
    (void)hipDeviceGetAttribute(&cus, hipDeviceAttributeMultiprocessorCount, dev);
    (void)hipFuncSetAttribute((const void*)fwd_kernel, hipFuncAttributeMaxDynamicSharedMemorySize, LDS_BYTES);
    (void)hipOccupancyMaxActiveBlocksPerMultiprocessor(&per_cu, (const void*)fwd_kernel, 512, LDS_BYTES);
    if (per_cu < 1) fprintf(stderr, "occupancy query says %d blocks/CU\n", per_cu);
    grid_blocks = cus;
    if (ws_size < WS_END + CTL_BYTES) { fprintf(stderr, "workspace too small: %zu < %zu\n", ws_size, (size_t)WS_END); grid_blocks = -1; }
    if (n_in != 27) { fprintf(stderr, "expected 27 inputs, got %d\n", n_in); grid_blocks = -1; }
  }
  if (grid_blocks < 0) return;
  (void)hipMemsetAsync((unsigned char*)d_ws + WS_END, 0, CTL_BYTES, stream);
  Params p{};
  for (int i = 0; i < 27; ++i) p.in[i] = (const float*)d_in[i];
  p.out = (float*)d_out; p.ws = (unsigned char*)d_ws;
  void* args[] = {&p};
  hipError_t e = hipLaunchCooperativeKernel((const void*)fwd_kernel, dim3(grid_blocks), dim3(512), args, LDS_BYTES, stream);
  if (e != hipSuccess) fprintf(stderr, "cooperative launch failed: %s (grid %d)\n", hipGetErrorString(e), grid_blocks);
}
```
